# Optimizing an MI355X kernel written in HIP

```python
import jax, jax.numpy as jnp
from jax import lax
import numpy as np

D_MODEL = 1024
BATCH = 8
SEQ = 2048
DEPTH = 1
DEC_BATCH = 128
DEC_SEQ = 8
PAST_LEN = 8192
PAGE_SIZE = 128

f32 = jnp.float32
MIX_WIDTH = D_MODEL
GLA_WIDTH = MIX_WIDTH // 2
GLA_HEADS = 4
GLA_DV = GLA_WIDTH // GLA_HEADS
GLA_DK = GLA_DV // 2
GLA_GATE_RANK = 16
GLA_TAU = 16.0
GLA_CHUNK = 64
SWA_WIDTH = MIX_WIDTH - GLA_WIDTH
HEAD_DIM = 64
N_Q_HEADS = SWA_WIDTH // HEAD_DIM
N_KV_HEADS = 2
GQA_GROUP = N_Q_HEADS // N_KV_HEADS
WINDOW = 128
ROPE_THETA = 10000.0
D_FF = 4 * D_MODEL
EPS = 1e-6
IN_SPLITS = (GLA_HEADS * GLA_DK, GLA_HEADS * GLA_DK, GLA_WIDTH, GLA_WIDTH, GLA_GATE_RANK,
             N_Q_HEADS * HEAD_DIM, N_KV_HEADS * HEAD_DIM, N_KV_HEADS * HEAD_DIM)
IN_WIDTH = sum(IN_SPLITS)
SPLIT_POINTS = tuple(int(p) for p in np.cumsum(IN_SPLITS)[:-1])

kernel_name = "hymba_gla_swa_sink_adaln_decoder_step"


def rms_norm(x, w):
    xf = x.astype(f32)
    y = xf * lax.rsqrt(jnp.mean(xf * xf, axis=-1, keepdims=True) + EPS) * w.astype(f32)
    return y.astype(x.dtype)


def rope(x, pos):
    half = HEAD_DIM // 2
    inv = jnp.power(ROPE_THETA, -jnp.arange(half, dtype=f32) * 2.0 / HEAD_DIM)
    ang = pos.astype(f32)[:, None] * inv[None, :]
    cos = jnp.cos(ang)[:, None, :]
    sin = jnp.sin(ang)[:, None, :]
    xf = x.astype(f32)
    x1, x2 = xf[..., :half], xf[..., half:]
    return jnp.concatenate([x1 * cos - x2 * sin, x2 * cos + x1 * sin], axis=-1).astype(x.dtype)


def gla_recurrence(q, k, v, log_a, s0):
    b, l, h, _ = q.shape
    dv = v.shape[-1]
    c = min(GLA_CHUNK, l)
    n = -(-l // c)
    pad = n * c - l
    if pad:
        padw = ((0, 0), (0, pad), (0, 0), (0, 0))
        q, k, v, log_a = [jnp.pad(t, padw) for t in (q, k, v, log_a)]

    def to_chunks(t):
        return t.astype(f32).reshape(b, n, c, h, t.shape[-1]).transpose(1, 0, 3, 2, 4)

    qc, kc, vc, ac = to_chunks(q), to_chunks(k), to_chunks(v), to_chunks(log_a)
    causal = jnp.tril(jnp.ones((c, c), bool))[:, :, None]

    def step(s, inp):
        qi, ki, vi, ai = inp
        bcum = jnp.cumsum(ai, axis=-2)
        diff = bcum[..., :, None, :] - bcum[..., None, :, :]
        decay = jnp.exp(jnp.where(causal, diff, -jnp.inf))
        attn = jnp.einsum('bhtd,bhsd,bhtsd->bhts', qi, ki, decay)
        o = (jnp.einsum('bhts,bhsv->bhtv', attn, vi)
             + jnp.einsum('bhtd,bhdv->bhtv', qi * jnp.exp(bcum), s))
        blast = bcum[..., -1:, :]
        s_new = (jnp.exp(blast)[..., 0, :, None] * s
                 + jnp.einsum('bhsd,bhsv->bhdv', ki * jnp.exp(blast - bcum), vi))
        return s_new, o

    s_fin, oc = lax.scan(step, s0.astype(f32), (qc, kc, vc, ac))
    o = oc.transpose(1, 0, 3, 2, 4).reshape(b, n * c, h, dv)[:, :l]
    return o, s_fin


def sink_attention(q, k, v, mask, sinks):
    s = jnp.einsum('...qhgd,...khd->...hgqk', q.astype(f32), k.astype(f32)) * (HEAD_DIM ** -0.5)
    s = jnp.where(mask, s, -jnp.inf)
    sink = sinks.astype(f32).reshape(N_KV_HEADS, GQA_GROUP, 1, 1)
    m = jnp.maximum(jnp.max(s, axis=-1, keepdims=True), sink)
    p = jnp.exp(s - m)
    denom = jnp.sum(p, axis=-1, keepdims=True) + jnp.exp(sink - m)
    return jnp.einsum('...hgqk,...khd->...qhgd', p / denom, v.astype(f32))


def swa_banded(q, k, v, sinks):
    b, t = q.shape[:2]
    nb = t // WINDOW
    qb = q.reshape(b, nb, WINDOW, N_KV_HEADS, GQA_GROUP, HEAD_DIM)

    def band(x):
        xb = x.reshape(b, nb, WINDOW, N_KV_HEADS, HEAD_DIM)
        prev = jnp.pad(xb, ((0, 0), (1, 0), (0, 0), (0, 0), (0, 0)))[:, :-1]
        return jnp.concatenate([prev, xb], axis=2)

    blk = jnp.arange(nb)[:, None]
    qpos = blk * WINDOW + jnp.arange(WINDOW)[None, :]
    kpos = (blk - 1) * WINDOW + jnp.arange(2 * WINDOW)[None, :]
    d = qpos[:, :, None] - kpos[:, None, :]
    mask = (d >= 0) & (d < WINDOW) & (kpos[:, None, :] >= 0)
    mask = mask[:, None, None]
    o = sink_attention(qb, band(k), band(v), mask, sinks)
    return o.reshape(b, t, SWA_WIDTH)


def swa_with_buffer(q, k, v, past_k, past_v, sinks):
    b, t = q.shape[:2]
    n_past = past_k.shape[1]
    keys = jnp.concatenate([past_k.astype(k.dtype), k], axis=1)
    vals = jnp.concatenate([past_v.astype(v.dtype), v], axis=1)
    qpos = jnp.arange(t)
    kpos = jnp.arange(n_past + t) - n_past
    d = qpos[:, None] - kpos[None, :]
    mask = ((d >= 0) & (d < WINDOW))[None, None]
    o = sink_attention(q.reshape(b, t, N_KV_HEADS, GQA_GROUP, HEAD_DIM), keys, vals, mask, sinks)
    return o.reshape(b, t, SWA_WIDTH), keys[:, -WINDOW:], vals[:, -WINDOW:]


def decoder_layer(x, c, pos, gla_state, past_k, past_v,
                  w_ada, b_ada, norm1_w, norm2_w, w_in, w_gate_up, b_gate, gla_norm_w,
                  q_norm_w, k_norm_w, sinks, w_out, w_ff1, w_ff2):
    bsz, t, _ = x.shape
    mod = jnp.einsum('bd,de->be', jax.nn.silu(c), w_ada) + b_ada
    sh1, sc1, g1, sh2, sc2, g2 = jnp.split(mod[:, None, :], 6, axis=-1)

    hn = rms_norm(x, norm1_w) * (1 + sc1) + sh1
    proj = jnp.einsum('btd,de->bte', hn, w_in)
    gq, gk, gv, gr, glr, sq, sk, sv = jnp.split(proj, SPLIT_POINTS, axis=-1)

    gq = gq.reshape(bsz, t, GLA_HEADS, GLA_DK) * (GLA_DK ** -0.5)
    gk = gk.reshape(bsz, t, GLA_HEADS, GLA_DK)
    gv = gv.reshape(bsz, t, GLA_HEADS, GLA_DV)
    gate_logit = (jnp.einsum('btr,re->bte', glr, w_gate_up) + b_gate).astype(f32)
    log_a = (jax.nn.log_sigmoid(gate_logit) / GLA_TAU).reshape(bsz, t, GLA_HEADS, GLA_DK)
    if gla_state is None:
        gla_state = jnp.zeros((bsz, GLA_HEADS, GLA_DK, GLA_DV), f32)
    go, gla_new = gla_recurrence(gq, gk, gv, log_a, gla_state)
    go = rms_norm(go, gla_norm_w) * jax.nn.silu(gr.reshape(bsz, t, GLA_HEADS, GLA_DV).astype(f32))
    go = go.reshape(bsz, t, GLA_WIDTH).astype(x.dtype)

    sq = rope(rms_norm(sq.reshape(bsz, t, N_Q_HEADS, HEAD_DIM), q_norm_w), pos)
    sk = rope(rms_norm(sk.reshape(bsz, t, N_KV_HEADS, HEAD_DIM), k_norm_w), pos)
    sv = sv.reshape(bsz, t, N_KV_HEADS, HEAD_DIM)
    if past_k is None:
        so = swa_banded(sq, sk, sv, sinks)
        k_keep, v_keep = sk[:, -WINDOW:], sv[:, -WINDOW:]
    else:
        so, k_keep, v_keep = swa_with_buffer(sq, sk, sv, past_k, past_v, sinks)

    mixed = jnp.einsum('bte,ed->btd', jnp.concatenate([go, so.astype(x.dtype)], axis=-1), w_out)
    h = x + g1 * mixed

    hn2 = rms_norm(h, norm2_w) * (1 + sc2) + sh2
    ff = jnp.einsum('btf,fd->btd', jnp.square(jax.nn.relu(jnp.einsum('btd,df->btf', hn2, w_ff1))), w_ff2)
    y = h + g2 * ff
    return y, gla_new, k_keep, v_keep


def setup_inputs(seed: int = 0) -> dict:
    key = jax.random.key(seed)
    ks = jax.random.split(key, 24)
    nrm = jax.random.normal
    return {
        "x_prompt": nrm(ks[0], (BATCH, SEQ, D_MODEL), f32),
        "x_sample": nrm(ks[1], (DEC_BATCH, DEC_SEQ, D_MODEL), f32),
        "state_gla": nrm(ks[2], (DEPTH, DEC_BATCH, GLA_HEADS, GLA_DK, GLA_DV), f32),
        "cache_swa_k": nrm(ks[3], (DEPTH, DEC_BATCH, WINDOW, N_KV_HEADS, HEAD_DIM), f32),
        "cache_swa_v": nrm(ks[4], (DEPTH, DEC_BATCH, WINDOW, N_KV_HEADS, HEAD_DIM), f32),
        "c_prompt": nrm(ks[5], (BATCH, D_MODEL), f32),
        "c_sample": nrm(ks[6], (DEC_BATCH, D_MODEL), f32),
        "w_ada": nrm(ks[7], (DEPTH, D_MODEL, 6 * D_MODEL), f32) * (0.5 * D_MODEL ** -0.5),
        "b_ada": nrm(ks[8], (DEPTH, 6 * D_MODEL), f32) * 0.01,
        "norm1_w": 1.0 + 0.1 * nrm(ks[9], (DEPTH, D_MODEL), f32),
        "norm2_w": 1.0 + 0.1 * nrm(ks[10], (DEPTH, D_MODEL), f32),
        "w_in": nrm(ks[11], (DEPTH, D_MODEL, IN_WIDTH), f32) * (D_MODEL ** -0.5),
        "w_gate_up": nrm(ks[12], (DEPTH, GLA_GATE_RANK, GLA_HEADS * GLA_DK), f32) * (GLA_GATE_RANK ** -0.5),
        "b_gate": nrm(ks[13], (DEPTH, GLA_HEADS * GLA_DK), f32) * 0.1,
        "gla_norm_w": 1.0 + 0.1 * nrm(ks[14], (DEPTH, GLA_DV), f32),
        "q_norm_w": 1.0 + 0.1 * nrm(ks[15], (DEPTH, HEAD_DIM), f32),
        "k_norm_w": 1.0 + 0.1 * nrm(ks[16], (DEPTH, HEAD_DIM), f32),
        "sinks": nrm(ks[17], (DEPTH, N_Q_HEADS), f32) * 0.5,
        "w_out": nrm(ks[18], (DEPTH, MIX_WIDTH, D_MODEL), f32) * (MIX_WIDTH ** -0.5),
        "w_ff1": nrm(ks[19], (DEPTH, D_MODEL, D_FF), f32) * (D_MODEL ** -0.5),
        "w_ff2": nrm(ks[20], (DEPTH, D_FF, D_MODEL), f32) * (D_FF ** -0.5),
    }


def reference(x_prompt, x_sample, state_gla, cache_swa_k, cache_swa_v, c_prompt, c_sample,
              w_ada, b_ada, norm1_w, norm2_w, w_in, w_gate_up, b_gate, gla_norm_w,
              q_norm_w, k_norm_w, sinks, w_out, w_ff1, w_ff2):
    pos_prompt = jnp.arange(x_prompt.shape[1])
    pos_sample = PAST_LEN + jnp.arange(x_sample.shape[1])
    yp, ys = x_prompt, x_sample
    gp_l, kp_l, vp_l, gs_l, ks_l, vs_l = [], [], [], [], [], []
    for l in range(DEPTH):
        lw = (w_ada[l], b_ada[l], norm1_w[l], norm2_w[l], w_in[l], w_gate_up[l], b_gate[l],
              gla_norm_w[l], q_norm_w[l], k_norm_w[l], sinks[l], w_out[l], w_ff1[l], w_ff2[l])
        yp, gp, kp, vp = decoder_layer(yp, c_prompt, pos_prompt, None, None, None, *lw)
        ys, gs, kq, vq = decoder_layer(ys, c_sample, pos_sample, state_gla[l],
                                       cache_swa_k[l], cache_swa_v[l], *lw)
        gp_l.append(gp); kp_l.append(kp); vp_l.append(vp)
        gs_l.append(gs); ks_l.append(kq); vs_l.append(vq)
    return (yp, ys,
            jnp.stack(gp_l), jnp.stack(kp_l), jnp.stack(vp_l),
            jnp.stack(gs_l), jnp.stack(ks_l), jnp.stack(vs_l))
```

```cpp
#include <hip/hip_runtime.h>
#include <hip/hip_bf16.h>
#include <cstdio>
#include <cstdint>
#include <cmath>
namespace pg8 {
#define PG8_LAS __attribute__((address_space(3)))
typedef unsigned short bf16_t;
typedef short bf16x8 __attribute__((ext_vector_type(8)));
typedef float f32x4 __attribute__((ext_vector_type(4)));
typedef unsigned u32x4 __attribute__((ext_vector_type(4)));
constexpr int BM = 256, BK = 64, HALF = 128, HTB = HALF * BK * 2  , STAGE_BYTES = 8 * HTB, NXCD = 8, WGM = 8;

__host__ __device__ __forceinline__ int lds_byte(int r, int c) { const int st = (r >> 4) * 2 + (c >> 5), rr = r & 15, cc = c & 31, ob = rr * 64 + cc * 2; return st * 1024 + (ob ^ (((ob >> 9) & 1) << 5)); }
__host__ __device__ __forceinline__ void stage_rc(int b, int& R, int& C) { const int st = b / 1024, sb = b % 1024, swz = sb ^ (((sb >> 9) & 1) << 5); R = (st >> 1) * 16 + swz / 64; C = (st & 1) * 32 + (swz % 64) / 2; }
__host__ __device__ __forceinline__ int perm32(int rho) { const int n = rho >> 4, i = rho & 15; return 8 * (i >> 2) + 4 * n + (i & 3); }

struct Unit { int pm, pn; };
struct Gemm { const bf16_t* A; const bf16_t* Bt; int M, N, K; };

struct StaticOrder {
    int nM, nN, nwg, G, c;
    __host__ __device__ void init(int M, int N, int G_, int c_) { nM = M / BM; nN = N / BM; nwg = nM * nN; G = G_; c = c_; }
    __host__ __device__ bool next(int i, Unit& u) const {
        const long L = (long)i * G + c; if (L >= nwg) return false;
        int wgid = (int)L; { const int q = nwg / NXCD, r = nwg % NXCD, xcd = wgid % NXCD, off = wgid / NXCD; wgid = (xcd < r ? xcd * (q + 1) : r * (q + 1) + (xcd - r) * q) + off; }
        const int nig = WGM * nN, gid = wgid / nig, fm = gid * WGM, gsz = (nM - fm) < WGM ? (nM - fm) : WGM;
        u.pm = fm + ((wgid % nig) % gsz); u.pn = (wgid % nig) / gsz; return true;
    }
    __device__ __forceinline__ void a_ready(const Unit&) const {}
    __device__ __forceinline__ void done(const Unit&) const {}
};

typedef float f32x2_t __attribute__((ext_vector_type(2))); typedef __bf16 bf16x2_t __attribute__((ext_vector_type(2)));
__device__ __forceinline__ unsigned cvt_pk_bf16(float lo, float hi) { f32x2_t v = {lo, hi}; bf16x2_t b = __builtin_convertvector(v, bf16x2_t); return __builtin_bit_cast(unsigned, b); }

struct EpiF32 {
    static constexpr bool PERM = false, AFTER_DRAIN = false;
    float* C; int ldc; const float* bias;
    __device__ __forceinline__ void operator()(const f32x4 (&acc)[2][2][4][2], const Unit& u, int wr, int wc, int fr, int fq) const {
        const int row0 = u.pm * BM + wr * 64 + fr, col0 = u.pn * BM + wc * 32 + 4 * fq;
        f32x4 bv[2][2];
#pragma unroll
        for (int bj = 0; bj < 2; ++bj)
#pragma unroll
            for (int n = 0; n < 2; ++n) bv[bj][n] = bias ? *(const f32x4*)(bias + col0 + bj * HALF + n * 16) : (f32x4){0.f, 0.f, 0.f, 0.f};
#pragma unroll
        for (int ai = 0; ai < 2; ++ai)
#pragma unroll
            for (int m = 0; m < 4; ++m) { float* rowp = C + (size_t)(row0 + ai * HALF + m * 16) * ldc + col0;
#pragma unroll
                for (int bj = 0; bj < 2; ++bj)
#pragma unroll
                    for (int n = 0; n < 2; ++n) *(f32x4*)(rowp + bj * HALF + n * 16) = acc[ai][bj][m][n] + bv[bj][n]; }
    }
};
template <int ACT  > struct EpiBf16 {
    static constexpr bool PERM = true, AFTER_DRAIN = false;
    bf16_t* O; int ldc;
    __device__ __forceinline__ void operator()(const f32x4 (&acc)[2][2][4][2], const Unit& u, int wr, int wc, int fr, int fq) const {
        const int row0 = u.pm * BM + wr * 64 + fr; const int colt = u.pn * BM;
        const int col0 = colt + wc * 32 + 8 * fq;
#pragma unroll
        for (int ai = 0; ai < 2; ++ai)
#pragma unroll
            for (int m = 0; m < 4; ++m) { bf16_t* rowp = O + (size_t)(row0 + ai * HALF + m * 16) * ldc + col0;
#pragma unroll
                for (int bj = 0; bj < 2; ++bj) { f32x4 v0 = acc[ai][bj][m][0], v1 = acc[ai][bj][m][1];
                    if (ACT == 2) {
#pragma unroll
                        for (int j = 0; j < 4; ++j) { const float a = __builtin_fmaxf(v0[j], 0.f), b = __builtin_fmaxf(v1[j], 0.f); v0[j] = a * a; v1[j] = b * b; } }
                    u32x4 w; w.x = cvt_pk_bf16(v0[0], v0[1]); w.y = cvt_pk_bf16(v0[2], v0[3]); w.z = cvt_pk_bf16(v1[0], v1[1]); w.w = cvt_pk_bf16(v1[2], v1[3]);
                    *(u32x4*)(rowp + bj * HALF) = w; } }
    }
};
struct EpiResGate {
    static constexpr bool PERM = false, AFTER_DRAIN = false;
    const float* baseP; const float* baseS; float* out; const float* gate; int gld;
    __device__ __forceinline__ void operator()(const f32x4 (&acc)[2][2][4][2], const Unit& u, int wr, int wc, int fr, int fq) const {
        const int row0 = u.pm * BM + wr * 64 + fr, col0 = u.pn * BM + wc * 32 + 4 * fq;
#pragma unroll
        for (int ai = 0; ai < 2; ++ai)
#pragma unroll
            for (int m = 0; m < 4; ++m) { const int row = row0 + ai * HALF + m * 16;
                const int mr = row < 16384 ? (row >> 11) : 8 + ((row - 16384) >> 3);
                const float* bp = (row < 16384 ? baseP + (size_t)row * 1024 : baseS + (size_t)(row - 16384) * 1024) + col0;
                const float* gp = gate + (size_t)mr * gld + col0; float* op = out + (size_t)row * 1024 + col0;
#pragma unroll
                for (int bj = 0; bj < 2; ++bj)
#pragma unroll
                    for (int n = 0; n < 2; ++n) { const f32x4 b = *(const f32x4*)(bp + bj * HALF + n * 16), g = *(const f32x4*)(gp + bj * HALF + n * 16);
                        *(f32x4*)(op + bj * HALF + n * 16) = b + g * acc[ai][bj][m][n]; } }
    }
};

template <class Epi, class Sched, bool ALIGN_EPI = false, bool SP2 = false>
__device__ __forceinline__ void gemm_phase(PG8_LAS unsigned char* lds, const Gemm g, const Sched& S, const Epi& E) {
    const int tid = threadIdx.x, wid = __builtin_amdgcn_readfirstlane(tid >> 6), lane = tid & 63, wr = wid >> 2, wc = wid & 3, fr = lane & 15, fq = lane >> 4;
    const int K = g.K, nt = K / BK;
    unsigned voffA[2], voffB[2];
#pragma unroll
    for (int i = 0; i < 2; ++i) { int R, C; stage_rc(tid * 16 + i * 8192, R, C); const int Rb = Epi::PERM ? ((R & ~31) + perm32(R & 31)) : R;
        voffA[i] = (unsigned)(R * K + C) * 2u; voffB[i] = (unsigned)(Rb * K + C) * 2u; }
    const size_t kstep = (size_t)(BK * 2);
    const size_t hstep = (size_t)HALF * K * 2;
    const size_t tstep = 2 * hstep;
    const unsigned ldsw = (unsigned)wid * 1024u;
    const int aoff = lds_byte(wr * 64 + fr, fq * 8), boff = lds_byte(wc * 32 + fr, fq * 8);
#define PG8_SA(b, h) (((b) * 2 + (h)) * HTB)
#define PG8_SB(b, h) ((4 + (b) * 2 + (h)) * HTB)
#define PG8_STAGE(bufoff, gbase, voff) do { _Pragma("unroll") for (int _i = 0; _i < 2; ++_i) \
        __builtin_amdgcn_global_load_lds((const unsigned*)((const char*)(gbase) + (voff)[_i]), (PG8_LAS unsigned*)(lds + (bufoff) + ldsw + _i * 8192), 16, 0, 0); } while (0)
#define PG8_LDA(dst, b, h) do { _Pragma("unroll") for (int m = 0; m < 4; ++m) _Pragma("unroll") for (int k = 0; k < 2; ++k) dst[m][k] = *(const PG8_LAS bf16x8*)(lds + PG8_SA(b, h) + aoff + m * 2048 + k * 1024); } while (0)
#define PG8_LDB(dst, b, h) do { _Pragma("unroll") for (int n = 0; n < 2; ++n) _Pragma("unroll") for (int k = 0; k < 2; ++k) dst[n][k] = *(const PG8_LAS bf16x8*)(lds + PG8_SB(b, h) + boff + n * 2048 + k * 1024); } while (0)
#define PG8_MMA(ai, bj, At, Bt) do { __builtin_amdgcn_s_setprio(1); _Pragma("unroll") for (int m = 0; m < 4; ++m) _Pragma("unroll") for (int n = 0; n < 2; ++n) _Pragma("unroll") for (int k = 0; k < 2; ++k) \
        acc[ai][bj][m][n] = __builtin_amdgcn_mfma_f32_16x16x32_bf16(Bt[n][k], At[m][k], acc[ai][bj][m][n], 0, 0, 0); __builtin_amdgcn_s_setprio(0); } while (0)
#define PG8_WAIT_V(n) asm volatile("s_waitcnt vmcnt(" #n ")" ::: "memory")
#define PG8_WAIT_L(n) asm volatile("s_waitcnt lgkmcnt(" #n ")" ::: "memory")
#define PG8_BAR __builtin_amdgcn_s_barrier()
#define PG8_SCHED __builtin_amdgcn_sched_barrier(0)
    Unit cur, nxt; int ui = 0;
    if (!S.next(0, cur)) return;
    f32x4 acc[2][2][4][2];
#pragma unroll
    for (int a = 0; a < 2; ++a)
#pragma unroll
        for (int b = 0; b < 2; ++b)
#pragma unroll
            for (int m = 0; m < 4; ++m)
#pragma unroll
                for (int n = 0; n < 2; ++n) acc[a][b][m][n] = (f32x4){0.f, 0.f, 0.f, 0.f};
    bf16x8 At[4][2], B0[2][2], B1[2][2];
    const char* cA = (const char*)g.A + (size_t)cur.pm * tstep; const char* cB = (const char*)g.Bt + (size_t)cur.pn * tstep;
    S.a_ready(cur);
    if constexpr (SP2) {
        PG8_STAGE(PG8_SB(0, 0), cB, voffB); PG8_STAGE(PG8_SB(0, 1), cB + hstep, voffB); PG8_STAGE(PG8_SA(0, 0), cA, voffA); PG8_STAGE(PG8_SA(0, 1), cA + hstep, voffA);
        if (wr == 1) PG8_BAR;
        PG8_WAIT_V(2); PG8_BAR;
        PG8_STAGE(PG8_SB(1, 0), cB + kstep, voffB); PG8_STAGE(PG8_SA(1, 0), cA + kstep, voffA); PG8_STAGE(PG8_SB(1, 1), cB + hstep + kstep, voffB);
        PG8_WAIT_V(6); PG8_BAR;
    } else {
        PG8_STAGE(PG8_SB(0, 0), cB, voffB); PG8_STAGE(PG8_SA(0, 0), cA, voffA); PG8_STAGE(PG8_SB(0, 1), cB + hstep, voffB); PG8_STAGE(PG8_SA(0, 1), cA + hstep, voffA);
        if (wr == 1) PG8_BAR;
        PG8_WAIT_V(4); PG8_BAR;
        PG8_STAGE(PG8_SB(1, 0), cB + kstep, voffB); PG8_STAGE(PG8_SA(1, 0), cA + kstep, voffA); PG8_STAGE(PG8_SB(1, 1), cB + hstep + kstep, voffB);
        PG8_WAIT_V(6); PG8_BAR;
    }
    for (;;) {
        const bool has_next = S.next(ui + 1, nxt);
        const char* nA = has_next ? (const char*)g.A + (size_t)nxt.pm * tstep : cA; const char* nB = has_next ? (const char*)g.Bt + (size_t)nxt.pn * tstep : cB;
        for (int t = 0; t < nt; t += 2) {
            const bool last = (t == nt - 2);
            const char* a1 = cA + (size_t)(t + 1) * kstep;
            const char* a2 = last ? nA : cA + (size_t)(t + 2) * kstep; const char* b2 = last ? nB : cB + (size_t)(t + 2) * kstep;
            const char* a3 = a2 + kstep; const char* b3 = b2 + kstep;
            if (last && has_next) S.a_ready(nxt);
            if constexpr (SP2) {
            PG8_LDB(B0, 0, 0); PG8_LDB(B1, 0, 1); PG8_SCHED; PG8_LDA(At, 0, 0); PG8_STAGE(PG8_SA(1, 1), a1 + hstep, voffA);
            PG8_WAIT_V(8); PG8_WAIT_L(0); PG8_BAR; PG8_MMA(0, 0, At, B0); PG8_MMA(0, 1, At, B1); PG8_BAR; PG8_SCHED;
            PG8_LDA(At, 0, 1); PG8_STAGE(PG8_SB(0, 0), b2, voffB); PG8_STAGE(PG8_SB(0, 1), b2 + hstep, voffB); PG8_STAGE(PG8_SA(0, 0), a2, voffA);
            PG8_WAIT_V(8); PG8_WAIT_L(0); PG8_BAR; PG8_MMA(1, 0, At, B0); PG8_MMA(1, 1, At, B1); PG8_BAR; PG8_SCHED;
            PG8_LDB(B0, 1, 0); PG8_LDB(B1, 1, 1); PG8_SCHED; PG8_LDA(At, 1, 0); PG8_STAGE(PG8_SA(0, 1), a2 + hstep, voffA);
            PG8_WAIT_V(8); PG8_WAIT_L(0); PG8_BAR; PG8_MMA(0, 0, At, B0); PG8_MMA(0, 1, At, B1); PG8_BAR; PG8_SCHED;
            PG8_LDA(At, 1, 1); PG8_STAGE(PG8_SB(1, 0), b3, voffB); PG8_STAGE(PG8_SB(1, 1), b3 + hstep, voffB); PG8_STAGE(PG8_SA(1, 0), a3, voffA);
            PG8_WAIT_V(8); PG8_WAIT_L(0); PG8_BAR; PG8_MMA(1, 0, At, B0); PG8_MMA(1, 1, At, B1); PG8_BAR; PG8_SCHED;
            } else {
            PG8_LDB(B0, 0, 0); PG8_SCHED; PG8_LDA(At, 0, 0); PG8_STAGE(PG8_SA(1, 1), a1 + hstep, voffA);
            PG8_WAIT_L(8); PG8_BAR; PG8_WAIT_L(0); PG8_MMA(0, 0, At, B0); PG8_BAR; PG8_SCHED;
            PG8_LDB(B1, 0, 1); PG8_STAGE(PG8_SB(0, 0), b2, voffB);
            PG8_BAR; PG8_WAIT_L(0); PG8_MMA(0, 1, At, B1); PG8_BAR;
            PG8_LDA(At, 0, 1); PG8_STAGE(PG8_SA(0, 0), a2, voffA);
            PG8_BAR; PG8_WAIT_L(0); PG8_MMA(1, 0, At, B0); PG8_BAR; PG8_SCHED;
            PG8_STAGE(PG8_SB(0, 1), b2 + hstep, voffB);
            PG8_WAIT_V(6); PG8_BAR; PG8_MMA(1, 1, At, B1); PG8_BAR;
            PG8_LDB(B0, 1, 0); PG8_SCHED; PG8_LDA(At, 1, 0); PG8_STAGE(PG8_SA(0, 1), a2 + hstep, voffA);
            PG8_WAIT_L(8); PG8_BAR; PG8_WAIT_L(0); PG8_MMA(0, 0, At, B0); PG8_BAR; PG8_SCHED;
            PG8_LDB(B1, 1, 1); PG8_STAGE(PG8_SB(1, 0), b3, voffB);
            PG8_BAR; PG8_WAIT_L(0); PG8_MMA(0, 1, At, B1); PG8_BAR;
            PG8_LDA(At, 1, 1); PG8_STAGE(PG8_SA(1, 0), a3, voffA);
            PG8_BAR; PG8_WAIT_L(0); PG8_MMA(1, 0, At, B0); PG8_BAR; PG8_SCHED;
            PG8_STAGE(PG8_SB(1, 1), b3 + hstep, voffB);
            PG8_WAIT_V(6); PG8_BAR; PG8_MMA(1, 1, At, B1); PG8_BAR;
            }
        }
        if constexpr (ALIGN_EPI) { if (wr == 0) PG8_BAR; }
        if constexpr (!Epi::AFTER_DRAIN) { E(acc, cur, wr, wc, fr, fq); S.done(cur); }
        if (!has_next) break;
#pragma unroll
        for (int a = 0; a < 2; ++a)
#pragma unroll
            for (int b = 0; b < 2; ++b)
#pragma unroll
                for (int m = 0; m < 4; ++m)
#pragma unroll
                    for (int n = 0; n < 2; ++n) acc[a][b][m][n] = (f32x4){0.f, 0.f, 0.f, 0.f};
        cur = nxt; cA = nA; cB = nB; ++ui;
        if constexpr (ALIGN_EPI) { if (wr == 1) PG8_BAR; }
    }
    PG8_WAIT_V(0);
    if constexpr (!ALIGN_EPI) { if (wr == 0) PG8_BAR; }
    PG8_BAR;
    if constexpr (Epi::AFTER_DRAIN) { E.fused(acc, cur, wr, wc, fr, fq, lds, wid, lane); S.done(cur); }
#undef PG8_SA
#undef PG8_SB
#undef PG8_STAGE
#undef PG8_LDA
#undef PG8_LDB
#undef PG8_MMA
#undef PG8_WAIT_V
#undef PG8_WAIT_L
#undef PG8_BAR
#undef PG8_SCHED
}
}
#define GAS __attribute__((address_space(1)))
#define LAS __attribute__((address_space(3)))
typedef unsigned short bf16;
typedef unsigned v4u __attribute__((ext_vector_type(4)));
typedef float f32x4 __attribute__((ext_vector_type(4)));
typedef short bf16x8 __attribute__((ext_vector_type(8)));
typedef GAS unsigned gu32;
typedef GAS unsigned long long gu64;
#define RLX_AGENT __ATOMIC_RELAXED, __HIP_MEMORY_SCOPE_AGENT
#define LDS_WAIT() asm volatile("s_waitcnt lgkmcnt(0)" ::: "memory")
#define VM_WAIT() asm volatile("s_waitcnt vmcnt(0)" ::: "memory")
__device__ __forceinline__ unsigned long long rt() { return __builtin_amdgcn_s_memrealtime(); }
__device__ __forceinline__ unsigned f2bf(float f) { unsigned u = __builtin_bit_cast(unsigned, f); return (u + 0x7fffu + ((u >> 16) & 1u)) >> 16; }
__device__ __forceinline__ unsigned pk2(float lo, float hi) { return f2bf(lo) | (f2bf(hi) << 16); }

#define XB_TMO      128
#define XB_XCNT(j)  (256  + 64 * (j))
#define XB_XSUB(j)  (1280 + 64 * (j))
#define XB_XGEN(j)  (2304 + 64 * (j))
#define XB_TOP      3328
#define XB_TOPGEN   3392
#define XCD_BAR_WORDS 3456
#define XB_SPIN_CAP (1u << 18)

__device__ __forceinline__ unsigned xb_ld(unsigned* p)              { return __hip_atomic_load(p, __ATOMIC_RELAXED, __HIP_MEMORY_SCOPE_AGENT); }
__device__ __forceinline__ unsigned xb_add(unsigned* p, unsigned v) { return __hip_atomic_fetch_add(p, v, __ATOMIC_RELAXED, __HIP_MEMORY_SCOPE_AGENT); }
__device__ __forceinline__ unsigned xb_xcc_id() { return (unsigned)__builtin_amdgcn_s_getreg((3 << 11) | 20) & 0xFu; }
#define XB_SPIN(cond, bar) do { unsigned _sp = 0; while (cond) { __builtin_amdgcn_s_sleep(1); \
    if ((++_sp & 255u) == 0u) { if (xb_ld(&(bar)[XB_TMO])) break; if (_sp > XB_SPIN_CAP) { atomicAdd(&(bar)[XB_TMO], 1u); break; } } } } while (0)

struct XcdBarrier {
    unsigned* bar; unsigned x;
    volatile LAS unsigned* st;
};

__device__ __forceinline__ XcdBarrier xcd_barrier_post(unsigned* bar, volatile LAS unsigned* st) {
    XcdBarrier b; b.bar = bar; b.x = xb_xcc_id(); b.st = st;
    if (threadIdx.x == 0) (void)xb_add(&bar[XB_XCNT(b.x)], 1u);
    return b;
}
__device__ __forceinline__ void xcd_barrier_complete(unsigned* bar, unsigned x, unsigned& nloc, unsigned& nx) {
    const unsigned G = gridDim.x * gridDim.y * gridDim.z;
    unsigned sum, cnt, mine, sp = 0u;
    for (;;) {
        sum = 0u; cnt = 0u; mine = 0u;
#pragma unroll
        for (unsigned j = 0; j < 16; ++j) { const unsigned c = xb_ld(&bar[XB_XCNT(j)]); sum += c; cnt += (c > 0u) ? 1u : 0u; mine = (j == x) ? c : mine; }
        if (sum == G) break;
        __builtin_amdgcn_s_sleep(1);
        if ((++sp & 255u) == 0u) { if (xb_ld(&bar[XB_TMO])) break; if (sp > XB_SPIN_CAP) { atomicAdd(&bar[XB_TMO], 1u); break; } }
    }
    nloc = mine > 0u ? mine : 1u; nx = cnt > 0u ? cnt : 1u;
}

__device__ __forceinline__ void xcd_barrier(const XcdBarrier& b) {
    asm volatile("s_waitcnt vmcnt(0)" ::: "memory");
    __syncthreads();
    if (threadIdx.x == 0) {
        unsigned* bar = b.bar;
        __builtin_amdgcn_s_waitcnt(0);
        unsigned nloc = b.st[0], nx = b.st[1];
        if (nloc == 0u) { xcd_barrier_complete(bar, b.x, nloc, nx); b.st[0] = nloc; b.st[1] = nx; }
        const unsigned old = xb_add(&bar[XB_XSUB(b.x)], 1u);
        const unsigned gen = old / nloc;
        if (old + 1u == (gen + 1u) * nloc) {
            __builtin_amdgcn_fence(__ATOMIC_RELEASE, "agent");
            asm volatile("s_waitcnt vmcnt(0)" ::: "memory");
            const unsigned og = xb_add(&bar[XB_TOP], 1u);
            const unsigned tg = og / nx;
            if (og + 1u == (tg + 1u) * nx) xb_add(&bar[XB_TOPGEN], 1u);
            else XB_SPIN(xb_ld(&bar[XB_TOPGEN]) == tg, bar);
            __builtin_amdgcn_fence(__ATOMIC_ACQUIRE, "agent");
            xb_add(&bar[XB_XGEN(b.x)], 1u);
            asm volatile("s_waitcnt vmcnt(0)" ::: "memory");
        } else {
            XB_SPIN(xb_ld(&bar[XB_XGEN(b.x)]) == gen, bar);
            __builtin_amdgcn_fence(__ATOMIC_ACQUIRE, "agent");
            asm volatile("s_waitcnt vmcnt(0)" ::: "memory");
        }
    }
    __syncthreads();
}

#define DI __device__ __forceinline__
constexpr int NWAVES = 8;
constexpr int D = 1024, NPR = 16384, NSM = 1024, MTOK = NPR + NSM, NIN = 2320, NINP = 2560, FF = 4096, NADA = 6144;
constexpr int C_GQ = 0, C_GK = 256, C_GV = 512, C_GR = 1024, C_GLR = 1536, C_SQ = 1552, C_SK = 2064, C_SV = 2192;
constexpr float EPS = 1e-6f;
constexpr float LOG2E = 1.4426950408889634f;
constexpr int NPOS = 2056;
constexpr size_t O_Y = 0, O_STP = 17825792, O_CKP = O_STP + 262144, O_CVP = O_CKP + 131072, O_STS = O_CVP + 131072, O_CKS = O_STS + 4194304, O_CVS = O_CKS + 2097152, O_END = O_CVS + 2097152;
static_assert(O_END == 26738688, "output size");
constexpr size_t MiB = 1u << 20;
constexpr size_t WS_CTL = 0, CTL_ZERO_BYTES = 1 * MiB;
constexpr size_t WS_ROPE = 1 * MiB, WS_SC = 2 * MiB, WS_MOD = 3 * MiB, WS_WIN = 9 * MiB, WS_WOUT = 14 * MiB, WS_W1 = 16 * MiB, WS_W2 = 24 * MiB, WS_WADA = 32 * MiB;
constexpr size_t WS_XN = 44 * MiB, WS_PROJ = 78 * MiB, WS_U = 163 * MiB, WS_GD = 195 * MiB, WS_MIX = 196 * MiB, WS_HID = 78 * MiB, WS_END = 230 * MiB;
static_assert(WS_PROJ + (size_t)MTOK * NINP * 2 <= WS_U && WS_XN + (size_t)MTOK * D * 2 <= WS_PROJ && WS_MIX + (size_t)MTOK * D * 2 <= WS_END && WS_HID + (size_t)MTOK * FF * 2 <= WS_END, "d_ws map");
constexpr int CW_BAR = 4096;
constexpr int RING_OFF = 0, RING_BYTES = 131072, LDSCTL_OFF = RING_BYTES, MISC_OFF = LDSCTL_OFF + 320, LDS_BYTES = 147456;

typedef short s16x4 __attribute__((ext_vector_type(4)));
typedef float f32x16 __attribute__((ext_vector_type(16)));
typedef short v4i16_t __attribute__((ext_vector_type(4)));
typedef unsigned u32x2 __attribute__((ext_vector_type(2)));

DI float bf2f(unsigned short b) { return __uint_as_float((unsigned)b << 16); }
DI float bfs2f(short b) { return __uint_as_float(((unsigned)(unsigned short)b) << 16); }
DI unsigned cvtpk(float lo, float hi) { return pg8::cvt_pk_bf16(lo, hi); }
DI float wave_sum(float v) {
#pragma unroll
    for (int o = 1; o < 64; o <<= 1) v += __shfl_xor(v, o);
    return v;
}
DI int crow(int r, int hi) { return (r & 3) + 8 * (r >> 2) + 4 * hi; }
DI s16x4 trrd(LAS const unsigned char* p) { return __builtin_bit_cast(s16x4, __builtin_amdgcn_ds_read_tr16_b64_v4i16((LAS v4i16_t*)p)); }
DI bf16x8 cat8(s16x4 lo, s16x4 hi) { return (bf16x8){lo[0], lo[1], lo[2], lo[3], hi[0], hi[1], hi[2], hi[3]}; }
DI float silu_f(float v) { return v / (1.f + __expf(-v)); }
DI float logsig_f(float x) { return -(__builtin_fmaxf(-x, 0.f) + __logf(1.f + __expf(-__builtin_fabsf(x)))); }
DI int modrow(int m) { return m < NPR ? (m >> 11) : 8 + ((m - NPR) >> 3); }
DI unsigned kswz(int row, int c) { return (unsigned)(row * 128 + ((c ^ ((row >> 1) & 7)) << 4)); }

struct Frame {
    LAS unsigned char* lds;
    volatile LAS unsigned* MISC;
    gu32* ctl;
    int tid, lane, wave, vcu, G;
    const float* const* in;
    float* out; unsigned char* ws;
    const float* invf;
};
#define IN_XP 0
#define IN_XS 1
#define IN_STATE 2
#define IN_CK 3
#define IN_CV 4
#define IN_CP 5
#define IN_CS 6
#define IN_WADA 7
#define IN_BADA 8
#define IN_N1 9
#define IN_N2 10
#define IN_WIN 11
#define IN_WGU 12
#define IN_BG 13
#define IN_GNW 14
#define IN_QNW 15
#define IN_KNW 16
#define IN_SINK 17
#define IN_WOUT 18
#define IN_WFF1 19
#define IN_WFF2 20

DI void p0_transpose_item(const float* W, int K, int N, int Npad, bf16* WT, LAS float* scr, int item, int lane) {
    const int nblk = Npad / 32, kb = item / nblk, nb = item % nblk, k0 = 64 * kb, n0 = 32 * nb;
    const int nn = n0 + (lane & 31); const bool ok = nn < N;
#pragma unroll 8
    for (int i = 0; i < 32; ++i) { const int kk = 2 * i + (lane >> 5); scr[kk * 33 + (lane & 31)] = ok ? W[(size_t)(k0 + kk) * N + nn] : 0.f; }
    LDS_WAIT(); asm volatile("" ::: "memory");
    const int c = lane & 7;
#pragma unroll
    for (int j = 0; j < 4; ++j) { const int n = (lane >> 3) + 8 * j; const LAS float* s = scr + (8 * c) * 33 + n;
        v4u o; o.x = cvtpk(s[0 * 33], s[1 * 33]); o.y = cvtpk(s[2 * 33], s[3 * 33]); o.z = cvtpk(s[4 * 33], s[5 * 33]); o.w = cvtpk(s[6 * 33], s[7 * 33]);
        *(GAS v4u*)(WT + (size_t)(n0 + n) * K + k0 + 8 * c) = o; }
    LDS_WAIT(); asm volatile("" ::: "memory");
}
DI void p0_prologue(Frame& F) {
    LAS float* scr = (LAS float*)(F.lds + RING_OFF + F.wave * 16384);
    const int gw = F.vcu * NWAVES + F.wave, NGW = F.G * NWAVES;
    bf16* Win_t = (bf16*)(F.ws + WS_WIN); bf16* Wout_t = (bf16*)(F.ws + WS_WOUT); bf16* W1_t = (bf16*)(F.ws + WS_W1); bf16* W2_t = (bf16*)(F.ws + WS_W2); bf16* Wada_t = (bf16*)(F.ws + WS_WADA);
    constexpr int I_ADA = (D / 64) * (NADA / 32), I_IN = (D / 64) * (NINP / 32), I_OUT = (D / 64) * (D / 32), I_1 = (D / 64) * (FF / 32), I_2 = (FF / 64) * (D / 32);
    constexpr int NITEMS = I_ADA + I_IN + I_OUT + I_1 + I_2;
    for (int it = gw; it < NITEMS; it += NGW) {
        int r = it;
        if (r < I_ADA) { p0_transpose_item(F.in[IN_WADA], D, NADA, NADA, Wada_t, scr, r, F.lane); continue; } r -= I_ADA;
        if (r < I_IN) { p0_transpose_item(F.in[IN_WIN], D, NIN, NINP, Win_t, scr, r, F.lane); continue; } r -= I_IN;
        if (r < I_OUT) { p0_transpose_item(F.in[IN_WOUT], D, D, D, Wout_t, scr, r, F.lane); continue; } r -= I_OUT;
        if (r < I_1) { p0_transpose_item(F.in[IN_WFF1], D, FF, FF, W1_t, scr, r, F.lane); continue; } r -= I_1;
        p0_transpose_item(F.in[IN_WFF2], FF, D, D, W2_t, scr, r, F.lane);
    }
    bf16* SC = (bf16*)(F.ws + WS_SC);
    for (int r = gw; r < 256; r += NGW) {
        const float* src = r < 8 ? F.in[IN_CP] + (size_t)r * D : (r < 136 ? F.in[IN_CS] + (size_t)(r - 8) * D : nullptr);
        GAS unsigned long long* o8 = (GAS unsigned long long*)(SC + (size_t)r * D) + F.lane;
#pragma unroll
        for (int j = 0; j < 4; ++j) { f32x4 v = (f32x4){0.f, 0.f, 0.f, 0.f}; if (src) v = *((const GAS f32x4*)src + F.lane + 64 * j);
            o8[64 * j] = (unsigned long long)cvtpk(silu_f(v.x), silu_f(v.y)) | ((unsigned long long)cvtpk(silu_f(v.z), silu_f(v.w)) << 32); }
    }
    float* ROPE = (float*)(F.ws + WS_ROPE);
    float invj = 0.f;
#pragma unroll
    for (int jj = 0; jj < 32; ++jj) invj = ((F.lane & 31) == jj) ? F.invf[jj] : invj;
    for (int idx = gw * 64 + F.lane; idx < NPOS * 32; idx += NGW * 64) {
        const int pi = idx >> 5, j = idx & 31; const int pos = pi < 2048 ? pi : 8192 + (pi - 2048);
        const float angf = (float)pos * invj;
        const double a = (double)angf; const double n = __builtin_rint(a * 0.63661977236758134308); const double rr = a - n * 1.57079632679489661923;
        const float x = (float)rr, x2 = x * x;
        const float s = x + x * x2 * (-1.6666654611e-1f + x2 * (8.3321608736e-3f + x2 * (-1.9515295891e-4f)));
        const float c = 1.f - 0.5f * x2 + x2 * x2 * (4.166664568298827e-2f + x2 * (-1.388731625493765e-3f + x2 * 2.443315711809948e-5f));
        const int q = ((int)n) & 3;
        const float sn = (q == 0) ? s : (q == 1) ? c : (q == 2) ? -s : -c;
        const float cs = (q == 0) ? c : (q == 1) ? -s : (q == 2) ? -c : s;
        ROPE[(size_t)pi * 64 + j] = cs; ROPE[(size_t)pi * 64 + 32 + j] = sn;
    }
}

DI void normmod_phase(Frame& F, bool second) {
    const int gw = F.vcu * NWAVES + F.wave, NGW = F.G * NWAVES;
    const float* nw = second ? F.in[IN_N2] : F.in[IN_N1];
    const float* MOD = (const float*)(F.ws + WS_MOD);
    const int sh_off = second ? 3072 : 0, sc_off = second ? 4096 : 1024;
    bf16* XN = (bf16*)(F.ws + WS_XN);
    for (int m = gw; m < MTOK; m += NGW) {
        const float* src = second ? F.out + O_Y + (size_t)m * D : (m < NPR ? F.in[IN_XP] + (size_t)m * D : F.in[IN_XS] + (size_t)(m - NPR) * D);
        const int mr = modrow(m);
        const GAS f32x4* xr = (const GAS f32x4*)src + F.lane;
        f32x4 v[4]; float s = 0.f;
#pragma unroll
        for (int j = 0; j < 4; ++j) { v[j] = xr[64 * j]; s += (v[j].x * v[j].x + v[j].y * v[j].y) + (v[j].z * v[j].z + v[j].w * v[j].w); }
        const float rstd = __builtin_amdgcn_rsqf(wave_sum(s) * (1.f / D) + EPS);
        const GAS f32x4* wr_ = (const GAS f32x4*)nw + F.lane; const GAS f32x4* scr_ = (const GAS f32x4*)(MOD + (size_t)mr * NADA + sc_off) + F.lane; const GAS f32x4* shr_ = (const GAS f32x4*)(MOD + (size_t)mr * NADA + sh_off) + F.lane;
        GAS unsigned long long* o8 = (GAS unsigned long long*)(XN + (size_t)m * D) + F.lane;
#pragma unroll
        for (int j = 0; j < 4; ++j) { const f32x4 w = wr_[64 * j], sc = scr_[64 * j], sh = shr_[64 * j];
            const f32x4 o = v[j] * rstd * w * (sc + 1.f) + sh;
            o8[64 * j] = (unsigned long long)cvtpk(o.x, o.y) | ((unsigned long long)cvtpk(o.z, o.w) << 32); }
    }
}

template <class MaskF>
DI void swa_tile(const bf16x8 (&qf)[4], LAS const unsigned char* Ks, LAS const unsigned char* Vs, int kt0, float sink2, MaskF valid, f32x16 (&o)[2], float& l_out, int lane) {
    const int r = lane & 31, h = lane >> 5;
    f32x16 p[5];
#pragma unroll
    for (int kt = 0; kt < 5; ++kt) {
        f32x16 acc;
#pragma unroll
        for (int i = 0; i < 16; ++i) acc[i] = 0.f;
        const int key = 32 * (kt0 + kt) + r;
#pragma unroll
        for (int s = 0; s < 4; ++s) { const bf16x8 a = *(LAS const bf16x8*)(Ks + kswz(key, 2 * s + h)); acc = __builtin_amdgcn_mfma_f32_32x32x16_bf16(a, qf[s], acc, 0, 0, 0); }
        p[kt] = acc;
    }
    float mx = sink2;
#pragma unroll
    for (int kt = 0; kt < 5; ++kt)
#pragma unroll
        for (int i = 0; i < 16; ++i) { const int key = 32 * (kt0 + kt) + crow(i, h); if (!valid(r, key)) p[kt][i] = -INFINITY; mx = __builtin_fmaxf(mx, p[kt][i]); }
    mx = __builtin_fmaxf(mx, __shfl_xor(mx, 32));
    float l = 0.f;
#pragma unroll
    for (int kt = 0; kt < 5; ++kt)
#pragma unroll
        for (int i = 0; i < 16; ++i) { const float e = __builtin_amdgcn_exp2f(p[kt][i] - mx); p[kt][i] = e; l += e; }
    l += __shfl_xor(l, 32); l += __builtin_amdgcn_exp2f(sink2 - mx);
#pragma unroll
    for (int i = 0; i < 16; ++i) { o[0][i] = 0.f; o[1][i] = 0.f; }
    const int q4 = (lane & 15) >> 2, p4 = lane & 3, blk = (lane >> 4) & 1;
#pragma unroll
    for (int kt = 0; kt < 5; ++kt)
#pragma unroll
        for (int s2 = 0; s2 < 2; ++s2) {
            v4u w; w.x = cvtpk(p[kt][8 * s2 + 0], p[kt][8 * s2 + 1]); w.y = cvtpk(p[kt][8 * s2 + 2], p[kt][8 * s2 + 3]); w.z = cvtpk(p[kt][8 * s2 + 4], p[kt][8 * s2 + 5]); w.w = cvtpk(p[kt][8 * s2 + 6], p[kt][8 * s2 + 7]);
            const bf16x8 pa = __builtin_bit_cast(bf16x8, w);
            const int krow0 = 32 * (kt0 + kt) + 16 * s2 + 4 * h + q4;
#pragma unroll
            for (int dh = 0; dh < 2; ++dh) {
                LAS const unsigned char* a0 = Vs + krow0 * 128 + (32 * dh + 16 * blk + 4 * p4) * 2;
                const s16x4 lo = trrd(a0), hi = trrd(a0 + 8 * 128);
                o[dh] = __builtin_amdgcn_mfma_f32_32x32x16_bf16(pa, cat8(lo, hi), o[dh], 0, 0, 0);
            }
        }
    l_out = l;
}
DI void make_qfrag(bf16x8 (&qf)[4], const bf16* qrow, const float* rope_row, const float* qnw, int h) {
    float x[4][8]; float ss = 0.f;
#pragma unroll
    for (int s = 0; s < 4; ++s) { const bf16x8 v = *(const GAS bf16x8*)(qrow + 16 * s + 8 * h);
#pragma unroll
        for (int j = 0; j < 8; ++j) { x[s][j] = bfs2f(v[j]); ss += x[s][j] * x[s][j]; } }
    ss += __shfl_xor(ss, 32);
    const float rstd = __builtin_amdgcn_rsqf(ss * (1.f / 64.f) + EPS);
#pragma unroll
    for (int s = 0; s < 4; ++s)
#pragma unroll
        for (int j = 0; j < 8; ++j) x[s][j] *= rstd * qnw[16 * s + 8 * h + j];
    constexpr float QS = 0.125f * LOG2E;
#pragma unroll
    for (int s = 0; s < 2; ++s)
#pragma unroll
        for (int j = 0; j < 8; ++j) { const float c = rope_row[16 * s + 8 * h + j], sn = rope_row[32 + 16 * s + 8 * h + j]; const float a = x[s][j], b = x[s + 2][j];
            x[s][j] = (a * c - b * sn) * QS; x[s + 2][j] = (b * c + a * sn) * QS; }
#pragma unroll
    for (int s = 0; s < 4; ++s) { v4u w; w.x = cvtpk(x[s][0], x[s][1]); w.y = cvtpk(x[s][2], x[s][3]); w.z = cvtpk(x[s][4], x[s][5]); w.w = cvtpk(x[s][6], x[s][7]); qf[s] = __builtin_bit_cast(bf16x8, w); }
}
DI void stage_k_new(LAS unsigned char* Ks, int key, int jq, const bf16* krow, const float* rope_row, const float* knw, float* cache_out) {
    float x1[8], x2[8]; float ss = 0.f;
    if (krow) { const bf16x8 v1 = *(const GAS bf16x8*)(krow + 8 * jq), v2 = *(const GAS bf16x8*)(krow + 32 + 8 * jq);
#pragma unroll
        for (int e = 0; e < 8; ++e) { x1[e] = bfs2f(v1[e]); x2[e] = bfs2f(v2[e]); ss += x1[e] * x1[e] + x2[e] * x2[e]; } }
    else {
#pragma unroll
        for (int e = 0; e < 8; ++e) { x1[e] = 0.f; x2[e] = 0.f; } }
    ss += __shfl_xor(ss, 1); ss += __shfl_xor(ss, 2);
    const float rstd = __builtin_amdgcn_rsqf(ss * (1.f / 64.f) + EPS);
    float o1[8], o2[8];
#pragma unroll
    for (int e = 0; e < 8; ++e) { const float a = x1[e] * rstd * knw[8 * jq + e], b = x2[e] * rstd * knw[32 + 8 * jq + e]; const float c = rope_row[8 * jq + e], sn = rope_row[32 + 8 * jq + e];
        o1[e] = a * c - b * sn; o2[e] = b * c + a * sn; }
    v4u w1, w2; w1.x = cvtpk(o1[0], o1[1]); w1.y = cvtpk(o1[2], o1[3]); w1.z = cvtpk(o1[4], o1[5]); w1.w = cvtpk(o1[6], o1[7]);
    w2.x = cvtpk(o2[0], o2[1]); w2.y = cvtpk(o2[2], o2[3]); w2.z = cvtpk(o2[4], o2[5]); w2.w = cvtpk(o2[6], o2[7]);
    *(LAS v4u*)(Ks + kswz(key, jq)) = w1; *(LAS v4u*)(Ks + kswz(key, 4 + jq)) = w2;
    if (cache_out) { *(GAS f32x4*)(cache_out + 8 * jq) = (f32x4){o1[0], o1[1], o1[2], o1[3]}; *(GAS f32x4*)(cache_out + 8 * jq + 4) = (f32x4){o1[4], o1[5], o1[6], o1[7]};
        *(GAS f32x4*)(cache_out + 32 + 8 * jq) = (f32x4){o2[0], o2[1], o2[2], o2[3]}; *(GAS f32x4*)(cache_out + 32 + 8 * jq + 4) = (f32x4){o2[4], o2[5], o2[6], o2[7]}; }
}

DI void swa_prompt_item(Frame& F, int item) {
    const int b = item >> 5, kvh = (item >> 4) & 1, i = item & 15;
    const bf16* PROJ = (const bf16*)(F.ws + WS_PROJ); bf16* MIX = (bf16*)(F.ws + WS_MIX); const float* ROPE = (const float*)(F.ws + WS_ROPE);
    LAS unsigned char* Ks = F.lds + RING_OFF; LAS unsigned char* Vs = F.lds + RING_OFF + 32768;
    const float* knw = F.in[IN_KNW]; const float* qnw = F.in[IN_QNW];
#pragma unroll 1
    for (int it = 0; it < 2; ++it) { const int task = F.tid + 512 * it, key = task >> 2, jq = task & 3; const int tok = 128 * (i - 1) + key;
        const bool ok = tok >= 0; const bf16* krow = ok ? PROJ + (size_t)(b * 2048 + tok) * NINP + C_SK + 64 * kvh : nullptr;
        float* co = (i == 15 && key >= 128) ? F.out + O_CKP + ((size_t)(b * 128 + (key - 128)) * 2 + kvh) * 64 : nullptr;
        stage_k_new(Ks, key, jq, krow, ROPE + (size_t)(ok ? tok : 0) * 64, knw, co); }
#pragma unroll 1
    for (int it = 0; it < 4; ++it) { const int id = F.tid + 512 * it, key = id >> 3, c = id & 7; const int tok = 128 * (i - 1) + key;
        v4u v = (v4u){0u, 0u, 0u, 0u}; if (tok >= 0) v = *(const GAS v4u*)(PROJ + (size_t)(b * 2048 + tok) * NINP + C_SV + 64 * kvh + 8 * c);
        *(LAS v4u*)(Vs + key * 128 + c * 16) = v;
        if (i == 15 && key >= 128) { float* co = F.out + O_CVP + ((size_t)(b * 128 + (key - 128)) * 2 + kvh) * 64 + 8 * c; const bf16x8 vv = __builtin_bit_cast(bf16x8, v);
            *(GAS f32x4*)co = (f32x4){bfs2f(vv[0]), bfs2f(vv[1]), bfs2f(vv[2]), bfs2f(vv[3])}; *(GAS f32x4*)(co + 4) = (f32x4){bfs2f(vv[4]), bfs2f(vv[5]), bfs2f(vv[6]), bfs2f(vv[7])}; } }
    __syncthreads();
    const int lane = F.lane, r = lane & 31, h = lane >> 5;
#pragma unroll 1
    for (int qi = 0; qi < 2; ++qi) {
        const int tq = F.wave * 2 + qi, hq = tq >> 2, o = 32 * (tq & 3), head = 4 * kvh + hq;
        const int tokq = 128 * i + o + r;
        bf16x8 qf[4];
        make_qfrag(qf, PROJ + (size_t)(b * 2048 + tokq) * NINP + C_SQ + 64 * head, ROPE + (size_t)tokq * 64, qnw, h);
        const float sink2 = F.in[IN_SINK][head] * LOG2E;
        f32x16 oacc[2]; float l;
        swa_tile(qf, Ks, Vs, tq & 3, sink2, [=](int rr, int idx) { return (idx > o + rr) && (idx <= o + rr + 128) && (i > 0 || idx >= 128); }, oacc, l, lane);
#pragma unroll
        for (int reg = 0; reg < 16; ++reg) { const int qq = crow(reg, h); const float rl = 1.f / __shfl(l, qq);
            bf16* op = MIX + (size_t)(b * 2048 + 128 * i + o + qq) * D + 512 + 64 * head + r;
            op[0] = (bf16)f2bf(oacc[0][reg] * rl); op[32] = (bf16)f2bf(oacc[1][reg] * rl); }
    }
    __syncthreads();
}
DI void swa_sample_item(Frame& F, int item) {
    const int b = item >> 1, kvh = item & 1;
    const bf16* PROJ = (const bf16*)(F.ws + WS_PROJ); bf16* MIX = (bf16*)(F.ws + WS_MIX); const float* ROPE = (const float*)(F.ws + WS_ROPE);
    LAS unsigned char* Ks = F.lds + RING_OFF; LAS unsigned char* Vs = F.lds + RING_OFF + 32768;
    const float* knw = F.in[IN_KNW]; const float* qnw = F.in[IN_QNW];
    const float* CK = F.in[IN_CK]; const float* CV = F.in[IN_CV];
#pragma unroll 1
    for (int it = 0; it < 2; ++it) { const int task = F.tid + 512 * it, key = task >> 2, jq = task & 3;
        if (task < 640) {
            if (key < 128) {
                const float* src = CK + ((size_t)(b * 128 + key) * 2 + kvh) * 64;
                const f32x4 a0 = *(const GAS f32x4*)(src + 8 * jq), a1 = *(const GAS f32x4*)(src + 8 * jq + 4), b0 = *(const GAS f32x4*)(src + 32 + 8 * jq), b1 = *(const GAS f32x4*)(src + 32 + 8 * jq + 4);
                v4u w1, w2; w1.x = cvtpk(a0.x, a0.y); w1.y = cvtpk(a0.z, a0.w); w1.z = cvtpk(a1.x, a1.y); w1.w = cvtpk(a1.z, a1.w);
                w2.x = cvtpk(b0.x, b0.y); w2.y = cvtpk(b0.z, b0.w); w2.z = cvtpk(b1.x, b1.y); w2.w = cvtpk(b1.z, b1.w);
                *(LAS v4u*)(Ks + kswz(key, jq)) = w1; *(LAS v4u*)(Ks + kswz(key, 4 + jq)) = w2;
                if (key >= 8) { float* co = F.out + O_CKS + ((size_t)(b * 128 + (key - 8)) * 2 + kvh) * 64;
                    *(GAS f32x4*)(co + 8 * jq) = a0; *(GAS f32x4*)(co + 8 * jq + 4) = a1; *(GAS f32x4*)(co + 32 + 8 * jq) = b0; *(GAS f32x4*)(co + 32 + 8 * jq + 4) = b1; }
            } else {
                const int t = key - 128; const bool ok = t < 8;
                const bf16* krow = ok ? PROJ + (size_t)(NPR + b * 8 + t) * NINP + C_SK + 64 * kvh : nullptr;
                float* co = ok ? F.out + O_CKS + ((size_t)(b * 128 + 120 + t) * 2 + kvh) * 64 : nullptr;
                stage_k_new(Ks, key, jq, krow, ROPE + (size_t)(2048 + (ok ? t : 0)) * 64, knw, co);
            }
        }
    }
#pragma unroll 1
    for (int it = 0; it < 3; ++it) { const int id = F.tid + 512 * it, key = id >> 3, c = id & 7;
        if (id < 1280) {
            v4u w = (v4u){0u, 0u, 0u, 0u};
            if (key < 128) { const float* src = CV + ((size_t)(b * 128 + key) * 2 + kvh) * 64 + 8 * c; const f32x4 a0 = *(const GAS f32x4*)src, a1 = *(const GAS f32x4*)(src + 4);
                w.x = cvtpk(a0.x, a0.y); w.y = cvtpk(a0.z, a0.w); w.z = cvtpk(a1.x, a1.y); w.w = cvtpk(a1.z, a1.w);
                if (key >= 8) { float* co = F.out + O_CVS + ((size_t)(b * 128 + (key - 8)) * 2 + kvh) * 64 + 8 * c; *(GAS f32x4*)co = a0; *(GAS f32x4*)(co + 4) = a1; } }
            else if (key < 136) { const int t = key - 128; w = *(const GAS v4u*)(PROJ + (size_t)(NPR + b * 8 + t) * NINP + C_SV + 64 * kvh + 8 * c); const bf16x8 vv = __builtin_bit_cast(bf16x8, w);
                float* co = F.out + O_CVS + ((size_t)(b * 128 + 120 + t) * 2 + kvh) * 64 + 8 * c;
                *(GAS f32x4*)co = (f32x4){bfs2f(vv[0]), bfs2f(vv[1]), bfs2f(vv[2]), bfs2f(vv[3])}; *(GAS f32x4*)(co + 4) = (f32x4){bfs2f(vv[4]), bfs2f(vv[5]), bfs2f(vv[6]), bfs2f(vv[7])}; }
            *(LAS v4u*)(Vs + key * 128 + c * 16) = w;
        }
    }
    __syncthreads();
    if (F.wave == 0) {
        const int lane = F.lane, r = lane & 31, h = lane >> 5; const int hq = r >> 3, t = r & 7, head = 4 * kvh + hq;
        bf16x8 qf[4];
        make_qfrag(qf, PROJ + (size_t)(NPR + b * 8 + t) * NINP + C_SQ + 64 * head, ROPE + (size_t)(2048 + t) * 64, qnw, h);
        const float sink2 = F.in[IN_SINK][head] * LOG2E;
        f32x16 oacc[2]; float l;
        swa_tile(qf, Ks, Vs, 0, sink2, [=](int rr, int idx) { const int tt = rr & 7; return (idx > tt) && (idx <= tt + 128); }, oacc, l, lane);
#pragma unroll
        for (int reg = 0; reg < 16; ++reg) { const int qq = crow(reg, h); const float rl = 1.f / __shfl(l, qq);
            bf16* op = MIX + (size_t)(NPR + b * 8 + (qq & 7)) * D + 512 + 64 * (4 * kvh + (qq >> 3)) + r;
            op[0] = (bf16)f2bf(oacc[0][reg] * rl); op[32] = (bf16)f2bf(oacc[1][reg] * rl); }
    }
    __syncthreads();
}

DI void gla_bcum(Frame& F, LAS unsigned char* l0, const bf16* proj0, int hh, float (&bc)[8], float& total) {
    LAS float* GLR = (LAS float*)l0; LAS float* TOT = (LAS float*)(l0 + 4096);
    const int d = F.tid & 63, g = F.tid >> 6;
    if (F.tid < 128) { const int t = F.tid >> 1, half = F.tid & 1; const bf16x8 v = *(const GAS bf16x8*)(proj0 + (size_t)t * NINP + C_GLR + 8 * half);
#pragma unroll
        for (int j = 0; j < 8; ++j) GLR[t * 16 + 8 * half + j] = bfs2f(v[j]); }
    __syncthreads();
    float w[16];
#pragma unroll
    for (int r = 0; r < 16; ++r) w[r] = F.in[IN_WGU][r * 256 + 64 * hh + d];
    const float bg = F.in[IN_BG][64 * hh + d];
    float c = 0.f;
#pragma unroll
    for (int tt = 0; tt < 8; ++tt) { float gl = bg;
#pragma unroll
        for (int r = 0; r < 16; ++r) gl += GLR[(8 * g + tt) * 16 + r] * w[r];
        c += logsig_f(gl) * (1.f / 16.f); bc[tt] = c; }
    TOT[g * 64 + d] = c;
    __syncthreads();
    float off = 0.f, tot = 0.f;
#pragma unroll
    for (int g2 = 0; g2 < 8; ++g2) { const float v = TOT[g2 * 64 + d]; tot += v; off += (g2 < g) ? v : 0.f; }
#pragma unroll
    for (int tt = 0; tt < 8; ++tt) bc[tt] += off;
    total = tot;
}
DI void g1_item(Frame& F, int item) {
    const int b = item >> 7, hh = (item >> 5) & 3, n = item & 31; const int tok0 = b * 2048 + 64 * n;
    const bf16* proj0 = (const bf16*)(F.ws + WS_PROJ) + (size_t)tok0 * NINP;
    LAS unsigned char* L = F.lds + RING_OFF; LAS unsigned char* KH = L + 8192; LAS unsigned char* VS = L + 16384;
    float bc[8], total; gla_bcum(F, L, proj0, hh, bc, total);
    const int d = F.tid & 63, g = F.tid >> 6;
#pragma unroll
    for (int tt = 0; tt < 8; ++tt) { const int t = 8 * g + tt; const float k = bf2f(proj0[(size_t)t * NINP + C_GK + 64 * hh + d]);
        *(LAS unsigned short*)(KH + t * 128 + d * 2) = (unsigned short)f2bf(k * __expf(total - bc[tt])); }
    if (g == 0) ((float*)(F.ws + WS_GD))[(size_t)item * 64 + d] = __expf(total);
#pragma unroll
    for (int it = 0; it < 2; ++it) { const int id = F.tid + 512 * it, t = id >> 4, c = id & 15;
        *(LAS v4u*)(VS + t * 256 + c * 16) = *(const GAS v4u*)(proj0 + (size_t)t * NINP + C_GV + 128 * hh + 8 * c); }
    __syncthreads();
    const int lane = F.lane, h = lane >> 5, q4 = (lane & 15) >> 2, p4 = lane & 3, blk = (lane >> 4) & 1;
    const int mt = F.wave >> 2, nt = F.wave & 3;
    f32x16 acc;
#pragma unroll
    for (int i = 0; i < 16; ++i) acc[i] = 0.f;
#pragma unroll
    for (int ks = 0; ks < 4; ++ks) { const int rowb = 16 * ks + 8 * h + q4;
        LAS const unsigned char* pa = KH + rowb * 128 + (32 * mt + 16 * blk + 4 * p4) * 2; LAS const unsigned char* pb = VS + rowb * 256 + (32 * nt + 16 * blk + 4 * p4) * 2;
        const bf16x8 a = cat8(trrd(pa), trrd(pa + 4 * 128)), bb = cat8(trrd(pb), trrd(pb + 4 * 256));
        acc = __builtin_amdgcn_mfma_f32_32x32x16_bf16(a, bb, acc, 0, 0, 0); }
    float* U = (float*)(F.ws + WS_U) + (size_t)item * 8192;
#pragma unroll
    for (int reg = 0; reg < 16; ++reg) U[(32 * mt + crow(reg, h)) * 128 + 32 * nt + (lane & 31)] = acc[reg];
    __syncthreads();
}
DI void g2_scan(Frame& F) {
    float* U = (float*)(F.ws + WS_U); const float* GD = (const float*)(F.ws + WS_GD);
    for (int c = F.vcu * 512 + F.tid; c < 65536; c += F.G * 512) {
        const int bh = c >> 11, d = (c >> 5) & 63, e4 = c & 31;
        f32x4 s = (f32x4){0.f, 0.f, 0.f, 0.f};
        float* p = U + (size_t)(bh * 32) * 8192 + d * 128 + 4 * e4; const float* gp = GD + (size_t)(bh * 32) * 64 + d;
#pragma unroll 1
        for (int n0 = 0; n0 < 32; n0 += 8) {
            f32x4 u[8]; float gg[8];
#pragma unroll
            for (int k = 0; k < 8; ++k) { u[k] = *(const GAS f32x4*)(p + (size_t)(n0 + k) * 8192); gg[k] = gp[(n0 + k) * 64]; }
#pragma unroll
            for (int k = 0; k < 8; ++k) { *(GAS f32x4*)(p + (size_t)(n0 + k) * 8192) = s; s = s * gg[k] + u[k]; }
        }
        *(GAS f32x4*)(F.out + O_STP + (size_t)bh * 8192 + d * 128 + 4 * e4) = s;
    }
}
DI void g3_item(Frame& F, int item) {
    const int b = item >> 7, hh = (item >> 5) & 3, n = item & 31; const int tok0 = b * 2048 + 64 * n;
    const bf16* proj0 = (const bf16*)(F.ws + WS_PROJ) + (size_t)tok0 * NINP;
    LAS unsigned char* L = F.lds + RING_OFF; LAS unsigned char* QT = L + 8192; LAS unsigned char* KT = L + 16384; LAS unsigned char* VS = L + 24576; LAS unsigned char* SB = L + 40960; LAS float* OB = (LAS float*)(L + 57344);
    float bc[8], total; gla_bcum(F, L, proj0, hh, bc, total);
    const int d = F.tid & 63, g = F.tid >> 6;
#pragma unroll
    for (int tt = 0; tt < 8; ++tt) { const int t = 8 * g + tt; const float q = bf2f(proj0[(size_t)t * NINP + C_GQ + 64 * hh + d]), k = bf2f(proj0[(size_t)t * NINP + C_GK + 64 * hh + d]);
        const float ep = __expf(bc[tt]), en = __expf(-bc[tt]);
        *(LAS unsigned short*)(QT + kswz(t, d >> 3) + (d & 7) * 2) = (unsigned short)f2bf(q * 0.125f * ep);
        *(LAS unsigned short*)(KT + kswz(t, d >> 3) + (d & 7) * 2) = (unsigned short)f2bf(k * en); }
#pragma unroll
    for (int it = 0; it < 2; ++it) { const int id = F.tid + 512 * it, t = id >> 4, c = id & 15;
        *(LAS v4u*)(VS + t * 256 + c * 16) = *(const GAS v4u*)(proj0 + (size_t)t * NINP + C_GV + 128 * hh + 8 * c); }
    const float* U = (const float*)(F.ws + WS_U) + (size_t)item * 8192;
#pragma unroll
    for (int it = 0; it < 4; ++it) { const int id = F.tid + 512 * it, dd = id >> 5, e4 = id & 31; const f32x4 s = *(const GAS f32x4*)(U + dd * 128 + 4 * e4);
        *(LAS u32x2*)(SB + dd * 256 + e4 * 8) = (u32x2){cvtpk(s.x, s.y), cvtpk(s.z, s.w)}; }
    __syncthreads();
    const int lane = F.lane, r = lane & 31, h = lane >> 5, q4 = (lane & 15) >> 2, p4 = lane & 3, blk = (lane >> 4) & 1;
    const int tt_ = F.wave >> 2, et = F.wave & 3;
    bf16x8 qfr[4];
#pragma unroll
    for (int s = 0; s < 4; ++s) qfr[s] = *(LAS const bf16x8*)(QT + kswz(32 * tt_ + r, 2 * s + h));
    f32x16 o;
#pragma unroll
    for (int i = 0; i < 16; ++i) o[i] = 0.f;
    const int colb = (32 * et + 16 * blk + 4 * p4) * 2;
#pragma unroll
    for (int st = 0; st < 2; ++st) {
        if (st <= tt_) {
            f32x16 pT;
#pragma unroll
            for (int i = 0; i < 16; ++i) pT[i] = 0.f;
#pragma unroll
            for (int s = 0; s < 4; ++s) { const bf16x8 a = *(LAS const bf16x8*)(KT + kswz(32 * st + r, 2 * s + h)); pT = __builtin_amdgcn_mfma_f32_32x32x16_bf16(a, qfr[s], pT, 0, 0, 0); }
            if (st == tt_) {
#pragma unroll
                for (int i = 0; i < 16; ++i) pT[i] = (crow(i, h) > r) ? 0.f : pT[i]; }
#pragma unroll
            for (int s2 = 0; s2 < 2; ++s2) {
                v4u w; w.x = cvtpk(pT[8 * s2 + 0], pT[8 * s2 + 1]); w.y = cvtpk(pT[8 * s2 + 2], pT[8 * s2 + 3]); w.z = cvtpk(pT[8 * s2 + 4], pT[8 * s2 + 5]); w.w = cvtpk(pT[8 * s2 + 6], pT[8 * s2 + 7]);
                const int rowb = 32 * st + 16 * s2 + 4 * h + q4; LAS const unsigned char* pb = VS + rowb * 256 + colb;
                o = __builtin_amdgcn_mfma_f32_32x32x16_bf16(__builtin_bit_cast(bf16x8, w), cat8(trrd(pb), trrd(pb + 8 * 256)), o, 0, 0, 0);
            }
        }
    }
#pragma unroll
    for (int s = 0; s < 4; ++s) { const int rowb = 16 * s + 8 * h + q4; LAS const unsigned char* pb = SB + rowb * 256 + colb;
        o = __builtin_amdgcn_mfma_f32_32x32x16_bf16(qfr[s], cat8(trrd(pb), trrd(pb + 4 * 256)), o, 0, 0, 0); }
#pragma unroll
    for (int reg = 0; reg < 16; ++reg) OB[(32 * tt_ + crow(reg, h)) * 132 + 32 * et + r] = o[reg];
    __syncthreads();
    {
        const int t = F.tid >> 3, seg = F.tid & 7; float v[16]; float ss = 0.f;
#pragma unroll
        for (int i = 0; i < 4; ++i) { const f32x4 x = *(LAS const f32x4*)(OB + t * 132 + 16 * seg + 4 * i); v[4 * i] = x.x; v[4 * i + 1] = x.y; v[4 * i + 2] = x.z; v[4 * i + 3] = x.w; ss += (x.x * x.x + x.y * x.y) + (x.z * x.z + x.w * x.w); }
        ss += __shfl_xor(ss, 1); ss += __shfl_xor(ss, 2); ss += __shfl_xor(ss, 4);
        const float rstd = __builtin_amdgcn_rsqf(ss * (1.f / 128.f) + EPS);
        const bf16* grp = proj0 + (size_t)t * NINP + C_GR + 128 * hh + 16 * seg; const float* gnw = F.in[IN_GNW] + 16 * seg;
        const bf16x8 g0 = *(const GAS bf16x8*)grp, g1 = *(const GAS bf16x8*)(grp + 8);
        float ov[16];
#pragma unroll
        for (int i = 0; i < 8; ++i) { ov[i] = v[i] * rstd * gnw[i] * silu_f(bfs2f(g0[i])); ov[8 + i] = v[8 + i] * rstd * gnw[8 + i] * silu_f(bfs2f(g1[i])); }
        bf16* op = (bf16*)(F.ws + WS_MIX) + (size_t)(tok0 + t) * D + 128 * hh + 16 * seg;
        v4u w0, w1; w0.x = cvtpk(ov[0], ov[1]); w0.y = cvtpk(ov[2], ov[3]); w0.z = cvtpk(ov[4], ov[5]); w0.w = cvtpk(ov[6], ov[7]);
        w1.x = cvtpk(ov[8], ov[9]); w1.y = cvtpk(ov[10], ov[11]); w1.z = cvtpk(ov[12], ov[13]); w1.w = cvtpk(ov[14], ov[15]);
        *(GAS v4u*)op = w0; *(GAS v4u*)(op + 8) = w1;
    }
    __syncthreads();
}
DI void gla_sample_item(Frame& F, int item) {
    const int b = item >> 2, hh = item & 3; const int tok0 = NPR + 8 * b;
    const bf16* proj0 = (const bf16*)(F.ws + WS_PROJ) + (size_t)tok0 * NINP;
    LAS float* L = (LAS float*)(F.lds + RING_OFF);
    LAS float* GLR = L;
    LAS float* QS = L + 128;
    LAS float* KS = L + 640;
    LAS float* KHs = L + 1152;
    LAS float* GDs = L + 1664;
    LAS float* AT = L + 1728;
    LAS float* VS = L + 1792;
    LAS float* S0s = L + 2816;
    const int tid = F.tid;
    if (tid < 16) { const int t = tid >> 1, half = tid & 1; const bf16x8 v = *(const GAS bf16x8*)(proj0 + (size_t)t * NINP + C_GLR + 8 * half);
#pragma unroll
        for (int j = 0; j < 8; ++j) GLR[t * 16 + 8 * half + j] = bfs2f(v[j]); }
    const float* S0 = F.in[IN_STATE] + (size_t)(b * 4 + hh) * 8192;
#pragma unroll
    for (int it = 0; it < 4; ++it) { const int id = tid + 512 * it; *(LAS f32x4*)(S0s + 4 * id) = *(const GAS f32x4*)(S0 + 4 * id); }
    if (tid < 128) { const int t = tid >> 4, c = tid & 15; const bf16x8 v = *(const GAS bf16x8*)(proj0 + (size_t)t * NINP + C_GV + 128 * hh + 8 * c);
#pragma unroll
        for (int j = 0; j < 8; ++j) VS[t * 128 + 8 * c + j] = bfs2f(v[j]); }
    __syncthreads();
    if (tid < 64) { const int d = tid; float w[16];
#pragma unroll
        for (int r = 0; r < 16; ++r) w[r] = F.in[IN_WGU][r * 256 + 64 * hh + d];
        const float bg = F.in[IN_BG][64 * hh + d]; float bcl[8]; float c = 0.f;
#pragma unroll
        for (int t = 0; t < 8; ++t) { float gl = bg;
#pragma unroll
            for (int r = 0; r < 16; ++r) gl += GLR[t * 16 + r] * w[r];
            c += logsig_f(gl) * (1.f / 16.f); bcl[t] = c; }
#pragma unroll
        for (int t = 0; t < 8; ++t) { const float q = bf2f(proj0[(size_t)t * NINP + C_GQ + 64 * hh + d]), k = bf2f(proj0[(size_t)t * NINP + C_GK + 64 * hh + d]);
            QS[t * 64 + d] = q * 0.125f * __expf(bcl[t]); KS[t * 64 + d] = k * __expf(-bcl[t]); KHs[t * 64 + d] = k * __expf(c - bcl[t]); }
        GDs[d] = __expf(c);
    }
    __syncthreads();
    if (tid < 64) { const int t = tid >> 3, s = tid & 7; float a = 0.f;
        for (int d = 0; d < 64; ++d) a += QS[t * 64 + d] * KS[s * 64 + d];
        AT[t * 8 + s] = (s <= t) ? a : 0.f; }
    __syncthreads();
    {
        const int t = F.wave, lane = F.lane; float o0 = 0.f, o1 = 0.f;
        for (int d = 0; d < 64; ++d) { const float q = QS[t * 64 + d]; o0 += q * S0s[d * 128 + lane]; o1 += q * S0s[d * 128 + 64 + lane]; }
#pragma unroll
        for (int s = 0; s < 8; ++s) { const float a = AT[t * 8 + s]; o0 += a * VS[s * 128 + lane]; o1 += a * VS[s * 128 + 64 + lane]; }
        const float rstd = __builtin_amdgcn_rsqf(wave_sum(o0 * o0 + o1 * o1) * (1.f / 128.f) + EPS);
        const bf16* grp = proj0 + (size_t)t * NINP + C_GR + 128 * hh; const float* gnw = F.in[IN_GNW];
        bf16* op = (bf16*)(F.ws + WS_MIX) + (size_t)(tok0 + t) * D + 128 * hh;
        op[lane] = (bf16)f2bf(o0 * rstd * gnw[lane] * silu_f(bf2f(grp[lane])));
        op[64 + lane] = (bf16)f2bf(o1 * rstd * gnw[64 + lane] * silu_f(bf2f(grp[64 + lane])));
    }
    float* So = F.out + O_STS + (size_t)(b * 4 + hh) * 8192;
#pragma unroll
    for (int it = 0; it < 4; ++it) { const int id = tid + 512 * it, d = id >> 5, e4 = id & 31; const f32x4 s0 = *(LAS const f32x4*)(S0s + d * 128 + 4 * e4); f32x4 a = s0 * GDs[d];
#pragma unroll
        for (int s = 0; s < 8; ++s) a += *(LAS const f32x4*)(VS + s * 128 + 4 * e4) * KHs[s * 64 + d];
        *(GAS f32x4*)(So + d * 128 + 4 * e4) = a; }
    __syncthreads();
}

struct Args { const float* in[21]; float* out; unsigned char* ws; float invf[32]; int ph_lo, ph_hi; };
constexpr int N_PHASES = 11;
__global__ void __launch_bounds__(NWAVES * 64, 2) fwd_kernel(Args args) {
    extern __shared__ __attribute__((aligned(16))) unsigned char lds[];
    Frame F;
    F.lds = (LAS unsigned char*)lds;
    F.MISC = (volatile LAS unsigned*)(F.lds + MISC_OFF);
    F.tid = threadIdx.x; F.lane = F.tid & 63; F.wave = __builtin_amdgcn_readfirstlane(F.tid >> 6);
    F.G = gridDim.x; { const int bx = blockIdx.x; F.vcu = (F.G % 8 == 0) ? (bx % 8) * (F.G / 8) + bx / 8 : bx; }
    F.in = args.in; F.out = args.out; F.ws = args.ws; F.invf = args.invf;
    F.ctl = (gu32*)(args.ws + WS_CTL);
    for (int u = F.tid; u < (LDS_BYTES - LDSCTL_OFF) / 4; u += NWAVES * 64) ((LAS unsigned*)(F.lds + LDSCTL_OFF))[u] = 0u;
    __syncthreads();
    const int lo = args.ph_lo, hi = args.ph_hi;
    const bool multi = (hi - lo) > 1;
    XcdBarrier bar; bar.bar = (unsigned*)(F.ctl + CW_BAR); bar.x = 0; bar.st = nullptr;
    if (multi) bar = xcd_barrier_post((unsigned*)(F.ctl + CW_BAR), F.MISC + 8);
#define IN(k) (lo <= (k) && (k) < hi)
#define SEAM(k) do { if (IN(k) && IN((k) + 1)) xcd_barrier(bar); } while (0)
    bf16* XN = (bf16*)(args.ws + WS_XN); float* MOD = (float*)(args.ws + WS_MOD);

    if (IN(0)) { p0_prologue(F); } SEAM(0);
    if (IN(1)) { pg8::Gemm g{(const pg8::bf16_t*)(args.ws + WS_SC), (const pg8::bf16_t*)(args.ws + WS_WADA), 256, NADA, D}; pg8::StaticOrder S; S.init(256, NADA, F.G, (int)blockIdx.x);
        pg8::EpiF32 E{MOD, NADA, args.in[IN_BADA]};
        pg8::gemm_phase<pg8::EpiF32, pg8::StaticOrder, true, true>(F.lds + RING_OFF, g, S, E); } SEAM(1);
    if (IN(2)) { normmod_phase(F, false); } SEAM(2);
    if (IN(3)) { pg8::Gemm g{XN, (const pg8::bf16_t*)(args.ws + WS_WIN), MTOK, NINP, D}; pg8::StaticOrder S; S.init(MTOK, NINP, F.G, (int)blockIdx.x);
        pg8::EpiBf16<0> E{(pg8::bf16_t*)(args.ws + WS_PROJ), NINP};
        pg8::gemm_phase<pg8::EpiBf16<0>, pg8::StaticOrder, true, true>(F.lds + RING_OFF, g, S, E); } SEAM(3);
    if (IN(4)) {
        for (int it = F.vcu; it < 256; it += F.G) swa_prompt_item(F, it);
        for (int it = F.vcu; it < 256; it += F.G) swa_sample_item(F, it);
        for (int it = F.vcu; it < 1024; it += F.G) g1_item(F, it);
        for (int it = F.vcu; it < 512; it += F.G) gla_sample_item(F, it);
    } SEAM(4);
    if (IN(5)) { g2_scan(F); } SEAM(5);
    if (IN(6)) { for (int it = F.vcu; it < 1024; it += F.G) g3_item(F, it); } SEAM(6);
    if (IN(7)) { pg8::Gemm g{(const pg8::bf16_t*)(args.ws + WS_MIX), (const pg8::bf16_t*)(args.ws + WS_WOUT), MTOK, D, D}; pg8::StaticOrder S; S.init(MTOK, D, F.G, (int)blockIdx.x);
        pg8::EpiResGate E{args.in[IN_XP], args.in[IN_XS], args.out + O_Y, MOD + 2048, NADA};
        pg8::gemm_phase<pg8::EpiResGate, pg8::StaticOrder, true, true>(F.lds + RING_OFF, g, S, E); } SEAM(7);
    if (IN(8)) { normmod_phase(F, true); } SEAM(8);
    if (IN(9)) { pg8::Gemm g{XN, (const pg8::bf16_t*)(args.ws + WS_W1), MTOK, FF, D}; pg8::StaticOrder S; S.init(MTOK, FF, F.G, (int)blockIdx.x);
        pg8::EpiBf16<2> E{(pg8::bf16_t*)(args.ws + WS_HID), FF};
        pg8::gemm_phase<pg8::EpiBf16<2>, pg8::StaticOrder, true, true>(F.lds + RING_OFF, g, S, E); } SEAM(9);
    if (IN(10)) { pg8::Gemm g{(const pg8::bf16_t*)(args.ws + WS_HID), (const pg8::bf16_t*)(args.ws + WS_W2), MTOK, D, FF}; pg8::StaticOrder S; S.init(MTOK, D, F.G, (int)blockIdx.x);
        pg8::EpiResGate E{args.out + O_Y, args.out + O_Y + (size_t)NPR * D, args.out + O_Y, MOD + 5120, NADA};
        pg8::gemm_phase<pg8::EpiResGate, pg8::StaticOrder, true, true>(F.lds + RING_OFF, g, S, E); }
#undef IN
#undef SEAM
}

#ifndef MK_LAUNCH_PER_PHASE
#define MK_LAUNCH_PER_PHASE 1
#endif
extern "C" void kernel_launch(void* const* d_in, const int* in_sizes, int n_in, void* d_out, int out_size, void* d_ws, size_t ws_size, hipStream_t stream) {
    static int grid = 0;
    if (grid == 0) {
        if (n_in != 21 || out_size != (int)O_END || ws_size < WS_END) { fprintf(stderr, "kernel_launch: unexpected shapes (n_in %d, out %d, ws %zu)\n", n_in, out_size, ws_size); grid = -1; return; }
        int dev = 0, cus = 0, per_cu = 0;
        if (hipGetDevice(&dev) != hipSuccess || hipDeviceGetAttribute(&cus, hipDeviceAttributeMultiprocessorCount, dev) != hipSuccess) { grid = -1; return; }
        if (hipFuncSetAttribute((const void*)fwd_kernel, hipFuncAttributeMaxDynamicSharedMemorySize, LDS_BYTES) != hipSuccess) { fprintf(stderr, "kernel_launch: hipFuncSetAttribute failed\n"); grid = -1; return; }
        if (hipOccupancyMaxActiveBlocksPerMultiprocessor(&per_cu, (const void*)fwd_kernel, NWAVES * 64, LDS_BYTES) != hipSuccess || per_cu < 1) { fprintf(stderr, "kernel_launch: occupancy query says %d\n", per_cu); }
        (void)hipGetLastError();
        grid = cus;
    }
    if (grid < 0) return;
    (void)hipMemsetAsync((char*)d_ws + WS_CTL, 0, CTL_ZERO_BYTES, stream);
    Args a{};
    for (int i = 0; i < 21; ++i) a.in[i] = (const float*)d_in[i];
    a.out = (float*)d_out; a.ws = (unsigned char*)d_ws;
    for (int j = 0; j < 32; ++j) a.invf[j] = (float)pow(10000.0, -(double)j / 32.0);
#if MK_LAUNCH_PER_PHASE
    for (int p = 0; p < N_PHASES; ++p) { a.ph_lo = p; a.ph_hi = p + 1; hipLaunchKernelGGL(fwd_kernel, dim3(grid), dim3(NWAVES * 64), LDS_BYTES, stream, a); }
#else
    a.ph_lo = 0; a.ph_hi = N_PHASES;
    hipLaunchKernelGGL(fwd_kernel, dim3(grid), dim3(NWAVES * 64), LDS_BYTES, stream, a);
#endif
}
```

```cpp
#include <hip/hip_runtime.h>
#include <hip/hip_bf16.h>
#include <cstdio>
#include <cstdint>
#include <cmath>
namespace pg8 {
#define PG8_LAS __attribute__((address_space(3)))
typedef unsigned short bf16_t;
typedef short bf16x8 __attribute__((ext_vector_type(8)));
typedef float f32x4 __attribute__((ext_vector_type(4)));
typedef unsigned u32x4 __attribute__((ext_vector_type(4)));
constexpr int BM = 256, BK = 64, HALF = 128, HTB = HALF * BK * 2  , STAGE_BYTES = 8 * HTB, NXCD = 8, WGM = 8;

__host__ __device__ __forceinline__ int lds_byte(int r, int c) { const int st = (r >> 4) * 2 + (c >> 5), rr = r & 15, cc = c & 31, ob = rr * 64 + cc * 2; return st * 1024 + (ob ^ (((ob >> 9) & 1) << 5)); }
__host__ __device__ __forceinline__ void stage_rc(int b, int& R, int& C) { const int st = b / 1024, sb = b % 1024, swz = sb ^ (((sb >> 9) & 1) << 5); R = (st >> 1) * 16 + swz / 64; C = (st & 1) * 32 + (swz % 64) / 2; }
__host__ __device__ __forceinline__ int perm32(int rho) { const int n = rho >> 4, i = rho & 15; return 8 * (i >> 2) + 4 * n + (i & 3); }

struct Unit { int pm, pn, kt0, nkt, slab; };
struct Gemm { const bf16_t* A; const bf16_t* Bt; int M, N, K, lda, ldb; unsigned long long* ts; };
#define PG8_TS(k) do { if (g.ts && threadIdx.x == 0) g.ts[k] = __builtin_amdgcn_s_memrealtime(); } while (0)

struct StaticOrder {
    int nM, nN, nwg, G, c, nkt;
    __host__ __device__ void init(int M, int N, int G_, int c_, int K_) { nM = M / BM; nN = N / BM; nwg = nM * nN; G = G_; c = c_; nkt = K_ / BK; }
    __host__ __device__ __forceinline__ bool next(int i, Unit& u) const {
        const long L = (long)i * G + c; if (L >= nwg) return false;
        return at((int)L, u); }
    __host__ __device__ __forceinline__ bool at(int L, Unit& u) const {
        u.kt0 = 0; u.nkt = nkt; u.slab = -1;
        int wgid = L; { const int q = nwg / NXCD, r = nwg % NXCD, xcd = wgid % NXCD, off = wgid / NXCD; wgid = (xcd < r ? xcd * (q + 1) : r * (q + 1) + (xcd - r) * q) + off; }
        const int nig = WGM * nN, gid = wgid / nig, fm = gid * WGM, gsz = (nM - fm) < WGM ? (nM - fm) : WGM;
        u.pm = fm + ((wgid % nig) % gsz); u.pn = (wgid % nig) / gsz; return true;
    }
    __device__ __forceinline__ void a_ready(const Unit&) const {}
    __device__ __forceinline__ void done(const Unit&) const {}
};

typedef float f32x2_t __attribute__((ext_vector_type(2))); typedef __bf16 bf16x2_t __attribute__((ext_vector_type(2)));
__device__ __forceinline__ unsigned cvt_pk_bf16(float lo, float hi) { f32x2_t v = {lo, hi}; bf16x2_t b = __builtin_convertvector(v, bf16x2_t); return __builtin_bit_cast(unsigned, b); }

#define PG8_WT_AUX 16
__device__ __forceinline__ void wt_store16(__amdgpu_buffer_rsrc_t rs, unsigned byte_off, u32x4 v) { __builtin_amdgcn_raw_buffer_store_b128(v, rs, (int)byte_off, 0, PG8_WT_AUX); }
__device__ __forceinline__ void cnt_arrive(unsigned* cnt) {
    asm volatile("s_waitcnt vmcnt(0)" ::: "memory");
    if ((threadIdx.x & 63) == 0) __hip_atomic_fetch_add(cnt, 1u, __ATOMIC_RELAXED, __HIP_MEMORY_SCOPE_AGENT);
}
__device__ __forceinline__ void cnt_wait(const unsigned* cnt, unsigned need) {
    if (threadIdx.x < 64) {
        unsigned spins = 0;
        while ((unsigned)__builtin_amdgcn_readfirstlane(__hip_atomic_load(cnt, __ATOMIC_RELAXED, __HIP_MEMORY_SCOPE_AGENT)) < need) { __builtin_amdgcn_s_sleep(4); if (++spins > (1u << 22)) break; }
        __builtin_amdgcn_fence(__ATOMIC_ACQUIRE, "agent");
        asm volatile("s_waitcnt vmcnt(0)" ::: "memory");
    }
    asm volatile("" ::: "memory"); __builtin_amdgcn_s_barrier(); asm volatile("" ::: "memory");
}
__device__ __forceinline__ void cnt_wait_nofence(const unsigned* cnt, unsigned need) {
    if (threadIdx.x < 64) {
        unsigned spins = 0;
        while ((unsigned)__builtin_amdgcn_readfirstlane(__hip_atomic_load(cnt, __ATOMIC_RELAXED, __HIP_MEMORY_SCOPE_AGENT)) < need) { __builtin_amdgcn_s_sleep(2); if (++spins > (1u << 22)) break; }
    }
    asm volatile("" ::: "memory"); __builtin_amdgcn_s_barrier(); asm volatile("" ::: "memory");
}
struct EpiF32 {
    static constexpr bool PERM = false, AFTER_DRAIN = false;
    float* C; int ldc; const float* bias;
    __device__ __forceinline__ void operator()(const f32x4 (&acc)[2][2][4][2], const Unit& u, int wr, int wc, int fr, int fq) const {
        const int row0 = u.pm * BM + wr * 64 + fr, col0 = u.pn * BM + wc * 32 + 4 * fq;
        f32x4 bv[2][2];
#pragma unroll
        for (int bj = 0; bj < 2; ++bj)
#pragma unroll
            for (int n = 0; n < 2; ++n) bv[bj][n] = bias ? *(const f32x4*)(bias + col0 + bj * HALF + n * 16) : (f32x4){0.f, 0.f, 0.f, 0.f};
#pragma unroll
        for (int ai = 0; ai < 2; ++ai)
#pragma unroll
            for (int m = 0; m < 4; ++m) { float* rowp = C + (size_t)(row0 + ai * HALF + m * 16) * ldc + col0;
#pragma unroll
                for (int bj = 0; bj < 2; ++bj)
#pragma unroll
                    for (int n = 0; n < 2; ++n) *(f32x4*)(rowp + bj * HALF + n * 16) = acc[ai][bj][m][n] + bv[bj][n]; }
    }
};
template <int ACT  > struct EpiBf16 {
    static constexpr bool PERM = true, AFTER_DRAIN = false;
    bf16_t* O; int ldc;
    __device__ __forceinline__ void operator()(const f32x4 (&acc)[2][2][4][2], const Unit& u, int wr, int wc, int fr, int fq) const {
        const int row0 = u.pm * BM + wr * 64 + fr; const int colt = u.pn * BM;
        const int col0 = colt + wc * 32 + 8 * fq;
#pragma unroll
        for (int ai = 0; ai < 2; ++ai)
#pragma unroll
            for (int m = 0; m < 4; ++m) { bf16_t* rowp = O + (size_t)(row0 + ai * HALF + m * 16) * ldc + col0;
#pragma unroll
                for (int bj = 0; bj < 2; ++bj) { f32x4 v0 = acc[ai][bj][m][0], v1 = acc[ai][bj][m][1];
                    if (ACT == 2) {
#pragma unroll
                        for (int j = 0; j < 4; ++j) { const float a = __builtin_fmaxf(v0[j], 0.f), b = __builtin_fmaxf(v1[j], 0.f); v0[j] = a * a; v1[j] = b * b; } }
                    u32x4 w; w.x = cvt_pk_bf16(v0[0], v0[1]); w.y = cvt_pk_bf16(v0[2], v0[3]); w.z = cvt_pk_bf16(v1[0], v1[1]); w.w = cvt_pk_bf16(v1[2], v1[3]);
                    *(u32x4*)(rowp + bj * HALF) = w; } }
    }
};
template <int MODE> struct EpiGate {
    static constexpr bool PERM = true, AFTER_DRAIN = false;
    const float* baseP; bf16_t* hb; float* y; const float* gate; int gld; float* slabs;
    __device__ __forceinline__ void operator()(const f32x4 (&acc)[2][2][4][2], const Unit& u, int wr, int wc, int fr, int fq) const {
        if (u.slab >= 0) {
            const __amdgpu_buffer_rsrc_t rs = __builtin_amdgcn_make_buffer_rsrc((void*)slabs, 0, 128 * 262144, 0x00020000);
            const unsigned so_ = (unsigned)(((size_t)u.slab * 65536 + (size_t)(wr * 64 + fr) * 256 + wc * 32 + 8 * fq) * 4);
#pragma unroll
            for (int ai = 0; ai < 2; ++ai)
#pragma unroll
                for (int m = 0; m < 4; ++m)
#pragma unroll
                    for (int bj = 0; bj < 2; ++bj)
#pragma unroll
                        for (int n = 0; n < 2; ++n) wt_store16(rs, so_ + (unsigned)(((ai * HALF + m * 16) * 256 + bj * HALF + n * 4) * 4), __builtin_bit_cast(u32x4, acc[ai][bj][m][n]));
            return;
        }
        const int row0 = u.pm * BM + wr * 64 + fr, col0 = u.pn * BM + wc * 32 + 8 * fq;
        const float* gp = gate + (size_t)(row0 >> 11) * gld + col0;
        f32x4 gv[2][2];
#pragma unroll
        for (int bj = 0; bj < 2; ++bj)
#pragma unroll
            for (int n = 0; n < 2; ++n) gv[bj][n] = *(const f32x4*)(gp + bj * HALF + n * 4);
#pragma unroll
        for (int ai = 0; ai < 2; ++ai)
#pragma unroll
            for (int m = 0; m < 4; ++m) { const int row = row0 + ai * HALF + m * 16; const size_t off = (size_t)row * 1024 + col0;
#pragma unroll
                for (int bj = 0; bj < 2; ++bj) {
                    if (MODE == 0) { const f32x4 b0 = __builtin_nontemporal_load((const f32x4*)(baseP + off + bj * HALF)), b1 = __builtin_nontemporal_load((const f32x4*)(baseP + off + bj * HALF + 4));
                        const f32x4 h0 = b0 + gv[bj][0] * acc[ai][bj][m][0], h1 = b1 + gv[bj][1] * acc[ai][bj][m][1];
                        u32x4 w; w.x = cvt_pk_bf16(h0[0], h0[1]); w.y = cvt_pk_bf16(h0[2], h0[3]); w.z = cvt_pk_bf16(h1[0], h1[1]); w.w = cvt_pk_bf16(h1[2], h1[3]);
                        *(u32x4*)(hb + off + bj * HALF) = w; }
                    else { const u32x4 hw = __builtin_nontemporal_load((const u32x4*)(hb + off + bj * HALF));
                        const f32x4 b0 = (f32x4){__uint_as_float(hw.x << 16), __uint_as_float(hw.x & 0xffff0000u), __uint_as_float(hw.y << 16), __uint_as_float(hw.y & 0xffff0000u)};
                        const f32x4 b1 = (f32x4){__uint_as_float(hw.z << 16), __uint_as_float(hw.z & 0xffff0000u), __uint_as_float(hw.w << 16), __uint_as_float(hw.w & 0xffff0000u)};
                        __builtin_nontemporal_store(b0 + gv[bj][0] * acc[ai][bj][m][0], (f32x4*)(y + off + bj * HALF)); __builtin_nontemporal_store(b1 + gv[bj][1] * acc[ai][bj][m][1], (f32x4*)(y + off + bj * HALF + 4)); }
                } }
    }
};

struct EpiOutNorm {
    static constexpr bool PERM = true, AFTER_DRAIN = false;
    const float* baseP; bf16_t* hb; bf16_t* xn; const float* mod; int gld; const float* n2w; float* xs; unsigned* cnt; PG8_LAS float* lx; float eps;
    __device__ __forceinline__ void operator()(const f32x4 (&acc)[2][2][4][2], const Unit& u, int wr, int wc, int fr, int fq) const {
        asm volatile("" : "+v"(fr), "+v"(fq));
        const int row0 = u.pm * BM + wr * 64 + fr, col0 = u.pn * BM + wc * 32 + 8 * fq;
        const float* mrow = mod + (size_t)(row0 >> 11) * gld;
        f32x4 (&hreg)[2][2][4][2] = const_cast<f32x4 (&)[2][2][4][2]>(acc);
        {
            f32x4 gv[2][2];
#pragma unroll
            for (int bj = 0; bj < 2; ++bj)
#pragma unroll
                for (int n = 0; n < 2; ++n) gv[bj][n] = *(const f32x4*)(mrow + 2048 + col0 + bj * HALF + n * 4);
#pragma unroll
            for (int ai = 0; ai < 2; ++ai)
#pragma unroll
                for (int m = 0; m < 4; ++m) { const int row = row0 + ai * HALF + m * 16; const size_t off = (size_t)row * 1024 + col0; float ss = 0.f;
#pragma unroll
                    for (int bj = 0; bj < 2; ++bj) {
                        const f32x4 b0 = __builtin_nontemporal_load((const f32x4*)(baseP + off + bj * HALF)), b1 = __builtin_nontemporal_load((const f32x4*)(baseP + off + bj * HALF + 4));
                        const f32x4 h0 = b0 + gv[bj][0] * acc[ai][bj][m][0], h1 = b1 + gv[bj][1] * acc[ai][bj][m][1];
                        hreg[ai][bj][m][0] = h0; hreg[ai][bj][m][1] = h1;
                        ss += (h0[0] * h0[0] + h0[1] * h0[1]) + (h0[2] * h0[2] + h0[3] * h0[3]) + (h1[0] * h1[0] + h1[1] * h1[1]) + (h1[2] * h1[2] + h1[3] * h1[3]);
                        u32x4 w; w.x = cvt_pk_bf16(h0[0], h0[1]); w.y = cvt_pk_bf16(h0[2], h0[3]); w.z = cvt_pk_bf16(h1[0], h1[1]); w.w = cvt_pk_bf16(h1[2], h1[3]);
                        *(u32x4*)(hb + off + bj * HALF) = w; }
                    ss += __shfl_xor(ss, 16); ss += __shfl_xor(ss, 32);
                    if (fq == 0) lx[(ai * HALF + wr * 64 + m * 16 + fr) * 4 + wc] = ss; }
        }
        __syncthreads();
        const int t = threadIdx.x;
        if (t < 256) { const f32x4 p = *(const PG8_LAS f32x4*)(lx + 4 * t);
            __hip_atomic_store(xs + ((size_t)u.pm * 256 + t) * 4 + u.pn, (p[0] + p[1]) + (p[2] + p[3]), __ATOMIC_RELAXED, __HIP_MEMORY_SCOPE_AGENT); }
        cnt_arrive(cnt + 32 * u.pm);
        cnt_wait_nofence(cnt + 32 * u.pm, 32u);
        if (t < 256) { const float* q = xs + ((size_t)u.pm * 256 + t) * 4;
            const float p0 = __hip_atomic_load(q, __ATOMIC_RELAXED, __HIP_MEMORY_SCOPE_AGENT), p1 = __hip_atomic_load(q + 1, __ATOMIC_RELAXED, __HIP_MEMORY_SCOPE_AGENT),
                        p2 = __hip_atomic_load(q + 2, __ATOMIC_RELAXED, __HIP_MEMORY_SCOPE_AGENT), p3 = __hip_atomic_load(q + 3, __ATOMIC_RELAXED, __HIP_MEMORY_SCOPE_AGENT);
            lx[1024 + t] = __builtin_amdgcn_rsqf(((p0 + p1) + (p2 + p3)) * (1.f / 1024.f) + eps); }
        __syncthreads();
#pragma unroll
        for (int bj = 0; bj < 2; ++bj) {
            f32x4 scw[2], shw[2];
#pragma unroll
            for (int n = 0; n < 2; ++n) { const int c = col0 + bj * HALF + n * 4;
                scw[n] = (*(const f32x4*)(mrow + 4096 + c) + 1.f) * *(const f32x4*)(n2w + c); shw[n] = *(const f32x4*)(mrow + 3072 + c); }
#pragma unroll
            for (int ai = 0; ai < 2; ++ai)
#pragma unroll
                for (int m = 0; m < 4; ++m) { const int row = row0 + ai * HALF + m * 16; const size_t off = (size_t)row * 1024 + col0; const float rstd = lx[1024 + ai * HALF + wr * 64 + m * 16 + fr];
                    const f32x4 o0 = hreg[ai][bj][m][0] * rstd * scw[0] + shw[0], o1 = hreg[ai][bj][m][1] * rstd * scw[1] + shw[1];
                    u32x4 w; w.x = cvt_pk_bf16(o0[0], o0[1]); w.y = cvt_pk_bf16(o0[2], o0[3]); w.z = cvt_pk_bf16(o1[0], o1[1]); w.w = cvt_pk_bf16(o1[2], o1[3]);
                    *(u32x4*)(xn + off + bj * HALF) = w; }
        }
    }
};

struct OutPOrder {
    int sup, nkt; const unsigned* cnt;
    __host__ __device__ void init(int sup_, int K) { sup = sup_; nkt = K / BK; }
    __host__ __device__ __forceinline__ bool next(int i, Unit& u) const { u.pm = (sup >> 5) * 8 + (sup & 7); u.pn = (sup >> 3) & 3; u.kt0 = 0; u.nkt = nkt; u.slab = -1; return i == 0; }
    __device__ __forceinline__ void a_ready(const Unit& u) const { cnt_wait(cnt + 32 * u.pm, 4u); }
    __device__ __forceinline__ void done(const Unit&) const {}
};
template <int NSPLIT> struct SubOnly {
    int nN, nS, c, nkt; unsigned* cnt;
    __host__ __device__ void init(int N, int c_, int K_) { nN = N / BM; nS = 4 * nN * NSPLIT; c = c_; nkt = K_ / BK; }
    __host__ __device__ __forceinline__ bool next(int i, Unit& u) const {
        const int s = c; const int un = s / NSPLIT, ks = s % NSPLIT;
        u.pm = 64 + un / nN; u.pn = un % nN; u.kt0 = ks * (nkt / NSPLIT); u.nkt = nkt / NSPLIT; u.slab = s;
        return i == 0 && c < nS;
    }
    __device__ __forceinline__ void a_ready(const Unit&) const {}
    __device__ __forceinline__ void done(const Unit& u) const { cnt_arrive(cnt + 32 * (u.pm - 64)); }
};

template <int NSPLIT> struct SplitOrder {
    StaticOrder so; int nP, nS, G, c, nkt;
    __host__ __device__ void init(int N, int G_, int c_, int K_) { so.init(16384, N, G_, c_, K_); nP = so.nwg; nS = 4 * (N / BM) * NSPLIT; G = G_; c = c_; nkt = K_ / BK; }
    __host__ __device__ __forceinline__ bool next(int i, Unit& u) const {
        const int nsub = c < nS ? (nS - c + G - 1) / G : 0; const bool isP = i >= nsub;
        const long L = isP ? (long)(i - nsub) * G + c : 0; const bool okP = L < nP;
        Unit a; so.at(okP ? (int)L : 0, a);
        const int s = isP ? 0 : c + i * G; const int un = s / NSPLIT, ks = s % NSPLIT; const int nN = so.nN;
        u.pm = isP ? a.pm : 64 + un / nN; u.pn = isP ? a.pn : un % nN; u.kt0 = isP ? 0 : ks * (nkt / NSPLIT); u.nkt = isP ? nkt : nkt / NSPLIT; u.slab = isP ? -1 : s;
        return isP ? okP : true;
    }
    __device__ __forceinline__ void a_ready(const Unit&) const {}
    __device__ __forceinline__ void done(const Unit&) const {}
};

struct Ff1Order {
    StaticOrder so; int nP, nS, G, c; unsigned* cnt; const unsigned* cntr;
    __host__ __device__ void init(int N, int G_, int c_, int K_) { so.init(16384, N, G_, c_, K_); nP = so.nwg; nS = 4 * (N / BM); G = G_; c = c_; }
    __host__ __device__ __forceinline__ bool next(int i, Unit& u) const {
        const bool hasS = c < nS; const bool isS = hasS && i == 2;
        const int ip = (hasS && i > 2) ? i - 1 : i;
        const long L = (long)ip * G + c; const bool okP = L < nP; const bool isP = !isS;
        Unit a; so.at(isP && okP ? (int)L : 0, a);
        const int s = isS ? c : 0; const int nN = so.nN;
        u.pm = isP ? a.pm : 64 + s / nN; u.pn = isP ? a.pn : s % nN; u.kt0 = 0; u.nkt = so.nkt; u.slab = -1;
        return isS || okP;
    }
    __device__ __forceinline__ void a_ready(const Unit& u) const { if (u.pm >= 64) cnt_wait(cntr + 32 * (u.pm - 64), 128u); }
    __device__ __forceinline__ void done(const Unit& u) const { cnt_arrive(cnt + 64 * u.pm); }
};
template <int ACT> struct EpiBf16WT {
    static constexpr bool PERM = true, AFTER_DRAIN = false;
    bf16_t* O; int ldc; size_t bytes;
    __device__ __forceinline__ void operator()(const f32x4 (&acc)[2][2][4][2], const Unit& u, int wr, int wc, int fr, int fq) const {
        const __amdgpu_buffer_rsrc_t rs = __builtin_amdgcn_make_buffer_rsrc((void*)O, 0, (int)bytes, 0x00020000);
        const int row0 = u.pm * BM + wr * 64 + fr; const int col0 = u.pn * BM + wc * 32 + 8 * fq;
#pragma unroll
        for (int ai = 0; ai < 2; ++ai)
#pragma unroll
            for (int m = 0; m < 4; ++m) { const unsigned ro = (unsigned)(((size_t)(row0 + ai * HALF + m * 16) * ldc + col0) * 2);
#pragma unroll
                for (int bj = 0; bj < 2; ++bj) { f32x4 v0 = acc[ai][bj][m][0], v1 = acc[ai][bj][m][1];
                    if (ACT == 2) {
#pragma unroll
                        for (int j = 0; j < 4; ++j) { const float a = __builtin_fmaxf(v0[j], 0.f), b = __builtin_fmaxf(v1[j], 0.f); v0[j] = a * a; v1[j] = b * b; } }
                    u32x4 w; w.x = cvt_pk_bf16(v0[0], v0[1]); w.y = cvt_pk_bf16(v0[2], v0[3]); w.z = cvt_pk_bf16(v1[0], v1[1]); w.w = cvt_pk_bf16(v1[2], v1[3]);
                    wt_store16(rs, ro + bj * HALF * 2, w); } }
    }
};
template <int NSPLIT> struct Ff2Order {
    StaticOrder so; int nP, nS, G, c, c0, nkt; const unsigned* cntp; unsigned* cnts;
    __host__ __device__ void init(int N, int G_, int c_, int K_, int c0_) { so.init(16384, N, G_, c_, K_); nP = so.nwg; nS = 4 * (N / BM) * NSPLIT; G = G_; c = c_; c0 = c0_; nkt = K_ / BK; }
    __host__ __device__ __forceinline__ bool next(int i, Unit& u) const {
        const int s = c - c0; const bool hasS = s >= 0 && s < nS;
        const bool isP = hasS ? (i == 1) : (i == 0);
        Unit a; so.at(c, a);
        const int ss = hasS ? s : 0; const int un = ss / NSPLIT, ks = ss % NSPLIT; const int nN = so.nN;
        u.pm = isP ? a.pm : 64 + un / nN; u.pn = isP ? a.pn : un % nN; u.kt0 = isP ? 0 : ks * (nkt / NSPLIT); u.nkt = isP ? nkt : nkt / NSPLIT; u.slab = isP ? -1 : ss;
        return hasS ? (i < 2) : (i == 0);
    }
    __device__ __forceinline__ void a_ready(const Unit& u) const { cnt_wait(cntp + 64 * u.pm, 128u); }
    __device__ __forceinline__ void done(const Unit& u) const { if (u.slab >= 0) cnt_arrive(cnts + 64 * (u.slab / NSPLIT)); }
};
struct AdaSplit { int c;
    __host__ __device__ __forceinline__ bool next(int i, Unit& u) const { u.pm = 0; u.pn = c >> 2; u.kt0 = 4 * (c & 3); u.nkt = 4; u.slab = c; return i == 0 && c < 96; }
    __device__ __forceinline__ void a_ready(const Unit&) const {}
    __device__ __forceinline__ void done(const Unit&) const {}
};
struct AdaRest { int c;
    __host__ __device__ __forceinline__ bool next(int i, Unit& u) const { u.pm = 0; u.pn = 8 + c; u.kt0 = 0; u.nkt = 16; u.slab = -1; return i == 0 && c < 16; }
    __device__ __forceinline__ void a_ready(const Unit&) const {}
    __device__ __forceinline__ void done(const Unit&) const {}
};
struct EpiSlab {
    static constexpr bool PERM = false, AFTER_DRAIN = false;
    float* slabs;
    __device__ __forceinline__ void operator()(const f32x4 (&acc)[2][2][4][2], const Unit& u, int wr, int wc, int fr, int fq) const {
        const __amdgpu_buffer_rsrc_t rs = __builtin_amdgcn_make_buffer_rsrc((void*)slabs, 0, 96 * 262144, 0x00020000);
        const unsigned so_ = (unsigned)(((size_t)u.slab * 65536 + (size_t)(wr * 64 + fr) * 256 + wc * 32 + 4 * fq) * 4);
#pragma unroll
        for (int ai = 0; ai < 2; ++ai)
#pragma unroll
            for (int m = 0; m < 4; ++m)
                if (ai * HALF + wr * 64 + m * 16 < 136) {
#pragma unroll
                for (int bj = 0; bj < 2; ++bj)
#pragma unroll
                    for (int n = 0; n < 2; ++n) wt_store16(rs, so_ + (unsigned)(((ai * HALF + m * 16) * 256 + bj * HALF + n * 16) * 4), __builtin_bit_cast(u32x4, acc[ai][bj][m][n]));
                }
    }
};

template <class Epi, class Sched, bool ALIGN_EPI = false, bool SP2 = false>
__device__ __forceinline__ void gemm_phase(PG8_LAS unsigned char* lds, const Gemm g, const Sched& S, const Epi& E) {
    int tid_ = threadIdx.x; asm volatile("" : "+v"(tid_));
    const int tid = tid_, wid = __builtin_amdgcn_readfirstlane(tid >> 6), lane = tid & 63, wr = wid >> 2, wc = wid & 3, fr = lane & 15, fq = lane >> 4;
    const int K = g.K;
    unsigned voffA[2], voffB[2];
#pragma unroll
    for (int i = 0; i < 2; ++i) { int R, C; stage_rc(tid * 16 + i * 8192, R, C); const int Rb = Epi::PERM ? ((R & ~31) + perm32(R & 31)) : R;
        voffA[i] = (unsigned)(R * g.lda + C) * 2u; voffB[i] = (unsigned)(Rb * g.ldb + C) * 2u; }
    const size_t kstep = (size_t)(BK * 2);
    const int lda = g.lda, ldb = g.ldb;
    const size_t hstepA = (size_t)HALF * lda * 2, hstepB = (size_t)HALF * ldb * 2;
    const size_t tstepA = 2 * hstepA, tstepB = 2 * hstepB;
    const unsigned ldsw = (unsigned)wid * 1024u;
    const int aoff = lds_byte(wr * 64 + fr, fq * 8), boff = lds_byte(wc * 32 + fr, fq * 8);
#define PG8_SA(b, h) (((b) * 2 + (h)) * HTB)
#define PG8_SB(b, h) ((4 + (b) * 2 + (h)) * HTB)
#define PG8_STAGE(bufoff, gbase, voff) do { _Pragma("unroll") for (int _i = 0; _i < 2; ++_i) \
        __builtin_amdgcn_global_load_lds((const unsigned*)((const char*)(gbase) + (voff)[_i]), (PG8_LAS unsigned*)(lds + (bufoff) + ldsw + _i * 8192), 16, 0, 0); } while (0)
#define PG8_LDA(dst, b, h) do { _Pragma("unroll") for (int m = 0; m < 4; ++m) _Pragma("unroll") for (int k = 0; k < 2; ++k) dst[m][k] = *(const PG8_LAS bf16x8*)(lds + PG8_SA(b, h) + aoff + m * 2048 + k * 1024); } while (0)
#define PG8_LDB(dst, b, h) do { _Pragma("unroll") for (int n = 0; n < 2; ++n) _Pragma("unroll") for (int k = 0; k < 2; ++k) dst[n][k] = *(const PG8_LAS bf16x8*)(lds + PG8_SB(b, h) + boff + n * 2048 + k * 1024); } while (0)
#define PG8_MMA(ai, bj, At, Bt) do { __builtin_amdgcn_s_setprio(1); _Pragma("unroll") for (int m = 0; m < 4; ++m) _Pragma("unroll") for (int n = 0; n < 2; ++n) _Pragma("unroll") for (int k = 0; k < 2; ++k) \
        acc[ai][bj][m][n] = __builtin_amdgcn_mfma_f32_16x16x32_bf16(Bt[n][k], At[m][k], acc[ai][bj][m][n], 0, 0, 0); __builtin_amdgcn_s_setprio(0); } while (0)
#define PG8_WAIT_V(n) asm volatile("s_waitcnt vmcnt(" #n ")" ::: "memory")
#define PG8_WAIT_L(n) asm volatile("s_waitcnt lgkmcnt(" #n ")" ::: "memory")
#define PG8_BAR __builtin_amdgcn_s_barrier()
#define PG8_SCHED __builtin_amdgcn_sched_barrier(0)
    Unit cur, nxt; int ui = 0;
    if (!S.next(0, cur)) return;
    PG8_TS(49);
    f32x4 acc[2][2][4][2];
#pragma unroll
    for (int a = 0; a < 2; ++a)
#pragma unroll
        for (int b = 0; b < 2; ++b)
#pragma unroll
            for (int m = 0; m < 4; ++m)
#pragma unroll
                for (int n = 0; n < 2; ++n) acc[a][b][m][n] = (f32x4){0.f, 0.f, 0.f, 0.f};
    bf16x8 At[4][2], B0[2][2], B1[2][2];
    const char* cA = (const char*)g.A + (size_t)cur.pm * tstepA + (size_t)cur.kt0 * kstep; const char* cB = (const char*)g.Bt + (size_t)cur.pn * tstepB + (size_t)cur.kt0 * kstep;
    S.a_ready(cur);
    if constexpr (SP2) {
        PG8_STAGE(PG8_SB(0, 0), cB, voffB); PG8_STAGE(PG8_SB(0, 1), cB + hstepB, voffB); PG8_STAGE(PG8_SA(0, 0), cA, voffA); PG8_STAGE(PG8_SA(0, 1), cA + hstepA, voffA);
        if (wr == 1) PG8_BAR;
        PG8_WAIT_V(2); PG8_BAR;
        PG8_STAGE(PG8_SB(1, 0), cB + kstep, voffB); PG8_STAGE(PG8_SA(1, 0), cA + kstep, voffA); PG8_STAGE(PG8_SB(1, 1), cB + hstepB + kstep, voffB);
        PG8_WAIT_V(6); PG8_BAR;
    } else {
        PG8_STAGE(PG8_SB(0, 0), cB, voffB); PG8_STAGE(PG8_SA(0, 0), cA, voffA); PG8_STAGE(PG8_SB(0, 1), cB + hstepB, voffB); PG8_STAGE(PG8_SA(0, 1), cA + hstepA, voffA);
        if (wr == 1) PG8_BAR;
        PG8_WAIT_V(4); PG8_BAR;
        PG8_STAGE(PG8_SB(1, 0), cB + kstep, voffB); PG8_STAGE(PG8_SA(1, 0), cA + kstep, voffA); PG8_STAGE(PG8_SB(1, 1), cB + hstepB + kstep, voffB);
        PG8_WAIT_V(6); PG8_BAR;
    }
    for (;;) {
        const bool has_next = S.next(ui + 1, nxt);
        const char* nA = has_next ? (const char*)g.A + (size_t)nxt.pm * tstepA + (size_t)nxt.kt0 * kstep : cA; const char* nB = has_next ? (const char*)g.Bt + (size_t)nxt.pn * tstepB + (size_t)nxt.kt0 * kstep : cB;
        const int nt = cur.nkt;
        for (int t = 0; t < nt; t += 2) {
            const bool last = (t == nt - 2);
            const char* a1 = cA + (size_t)(t + 1) * kstep;
            const char* a2 = last ? nA : cA + (size_t)(t + 2) * kstep; const char* b2 = last ? nB : cB + (size_t)(t + 2) * kstep;
            const char* a3 = a2 + kstep; const char* b3 = b2 + kstep;
            if (last && has_next) S.a_ready(nxt);
            if constexpr (SP2) {
            PG8_LDB(B0, 0, 0); PG8_LDB(B1, 0, 1); PG8_SCHED; PG8_LDA(At, 0, 0); PG8_STAGE(PG8_SA(1, 1), a1 + hstepA, voffA);
            PG8_WAIT_V(8); PG8_WAIT_L(0); PG8_BAR; PG8_MMA(0, 0, At, B0); PG8_MMA(0, 1, At, B1); PG8_BAR; PG8_SCHED;
            PG8_LDA(At, 0, 1); PG8_STAGE(PG8_SB(0, 0), b2, voffB); PG8_STAGE(PG8_SB(0, 1), b2 + hstepB, voffB); PG8_STAGE(PG8_SA(0, 0), a2, voffA);
            PG8_WAIT_V(8); PG8_WAIT_L(0); PG8_BAR; PG8_MMA(1, 0, At, B0); PG8_MMA(1, 1, At, B1); PG8_BAR; PG8_SCHED;
            PG8_LDB(B0, 1, 0); PG8_LDB(B1, 1, 1); PG8_SCHED; PG8_LDA(At, 1, 0); PG8_STAGE(PG8_SA(0, 1), a2 + hstepA, voffA);
            PG8_WAIT_V(8); PG8_WAIT_L(0); PG8_BAR; PG8_MMA(0, 0, At, B0); PG8_MMA(0, 1, At, B1); PG8_BAR; PG8_SCHED;
            PG8_LDA(At, 1, 1); PG8_STAGE(PG8_SB(1, 0), b3, voffB); PG8_STAGE(PG8_SB(1, 1), b3 + hstepB, voffB); PG8_STAGE(PG8_SA(1, 0), a3, voffA);
            PG8_WAIT_V(8); PG8_WAIT_L(0); PG8_BAR; PG8_MMA(1, 0, At, B0); PG8_MMA(1, 1, At, B1); PG8_BAR; PG8_SCHED;
            } else {
            PG8_LDB(B0, 0, 0); PG8_SCHED; PG8_LDA(At, 0, 0); PG8_STAGE(PG8_SA(1, 1), a1 + hstepA, voffA);
            PG8_WAIT_L(8); PG8_BAR; PG8_WAIT_L(0); PG8_MMA(0, 0, At, B0); PG8_BAR; PG8_SCHED;
            PG8_LDB(B1, 0, 1); PG8_STAGE(PG8_SB(0, 0), b2, voffB);
            PG8_BAR; PG8_WAIT_L(0); PG8_MMA(0, 1, At, B1); PG8_BAR;
            PG8_LDA(At, 0, 1); PG8_STAGE(PG8_SA(0, 0), a2, voffA);
            PG8_BAR; PG8_WAIT_L(0); PG8_MMA(1, 0, At, B0); PG8_BAR; PG8_SCHED;
            PG8_STAGE(PG8_SB(0, 1), b2 + hstepB, voffB);
            PG8_WAIT_V(6); PG8_BAR; PG8_MMA(1, 1, At, B1); PG8_BAR;
            PG8_LDB(B0, 1, 0); PG8_SCHED; PG8_LDA(At, 1, 0); PG8_STAGE(PG8_SA(0, 1), a2 + hstepA, voffA);
            PG8_WAIT_L(8); PG8_BAR; PG8_WAIT_L(0); PG8_MMA(0, 0, At, B0); PG8_BAR; PG8_SCHED;
            PG8_LDB(B1, 1, 1); PG8_STAGE(PG8_SB(1, 0), b3, voffB);
            PG8_BAR; PG8_WAIT_L(0); PG8_MMA(0, 1, At, B1); PG8_BAR;
            PG8_LDA(At, 1, 1); PG8_STAGE(PG8_SA(1, 0), a3, voffA);
            PG8_BAR; PG8_WAIT_L(0); PG8_MMA(1, 0, At, B0); PG8_BAR; PG8_SCHED;
            PG8_STAGE(PG8_SB(1, 1), b3 + hstepB, voffB);
            PG8_WAIT_V(6); PG8_BAR; PG8_MMA(1, 1, At, B1); PG8_BAR;
            }
        }
        if constexpr (ALIGN_EPI) { if (wr == 0) PG8_BAR; }
        PG8_TS(50 + 2 * (ui < 3 ? ui : 3));
        if constexpr (!Epi::AFTER_DRAIN) { E(acc, cur, wr, wc, fr, fq); S.done(cur); }
        PG8_TS(51 + 2 * (ui < 3 ? ui : 3));
        if (!has_next) break;
#pragma unroll
        for (int a = 0; a < 2; ++a)
#pragma unroll
            for (int b = 0; b < 2; ++b)
#pragma unroll
                for (int m = 0; m < 4; ++m)
#pragma unroll
                    for (int n = 0; n < 2; ++n) acc[a][b][m][n] = (f32x4){0.f, 0.f, 0.f, 0.f};
        cur = nxt; cA = nA; cB = nB; ++ui;
        if constexpr (ALIGN_EPI) { if (wr == 1) PG8_BAR; }
    }
    PG8_WAIT_V(0);
    if constexpr (!ALIGN_EPI) { if (wr == 0) PG8_BAR; }
    PG8_BAR;
    if constexpr (Epi::AFTER_DRAIN) { E.fused(acc, cur, wr, wc, fr, fq, lds, wid, lane); S.done(cur); }
#undef PG8_SA
#undef PG8_SB
#undef PG8_STAGE
#undef PG8_LDA
#undef PG8_LDB
#undef PG8_MMA
#undef PG8_WAIT_V
#undef PG8_WAIT_L
#undef PG8_BAR
#undef PG8_SCHED
}
}
#define GAS __attribute__((address_space(1)))
#define LAS __attribute__((address_space(3)))
typedef unsigned short bf16;
typedef unsigned v4u __attribute__((ext_vector_type(4)));
typedef float f32x4 __attribute__((ext_vector_type(4)));
typedef short bf16x8 __attribute__((ext_vector_type(8)));
typedef GAS unsigned gu32;
typedef GAS unsigned long long gu64;
#define RLX_AGENT __ATOMIC_RELAXED, __HIP_MEMORY_SCOPE_AGENT
#define LDS_WAIT() asm volatile("s_waitcnt lgkmcnt(0)" ::: "memory")
#define VM_WAIT() asm volatile("s_waitcnt vmcnt(0)" ::: "memory")
__device__ __forceinline__ unsigned long long rt() { return __builtin_amdgcn_s_memrealtime(); }
__device__ __forceinline__ unsigned f2bf(float f) { unsigned u = __builtin_bit_cast(unsigned, f); return (u + 0x7fffu + ((u >> 16) & 1u)) >> 16; }
__device__ __forceinline__ unsigned pk2(float lo, float hi) { return f2bf(lo) | (f2bf(hi) << 16); }

#define XB_TMO      128
#define XB_XCNT(j)  (256  + 64 * (j))
#define XB_XSUB(j)  (1280 + 64 * (j))
#define XB_XGEN(j)  (2304 + 64 * (j))
#define XB_TOP      3328
#define XB_TOPGEN   3392
#define XCD_BAR_WORDS 3456
#define XB_SPIN_CAP (1u << 18)

__device__ __forceinline__ unsigned xb_ld(unsigned* p)              { return __hip_atomic_load(p, __ATOMIC_RELAXED, __HIP_MEMORY_SCOPE_AGENT); }
__device__ __forceinline__ unsigned xb_add(unsigned* p, unsigned v) { return __hip_atomic_fetch_add(p, v, __ATOMIC_RELAXED, __HIP_MEMORY_SCOPE_AGENT); }
__device__ __forceinline__ unsigned xb_xcc_id() { return (unsigned)__builtin_amdgcn_s_getreg((3 << 11) | 20) & 0xFu; }
#define XB_SPIN(cond, bar) do { unsigned _sp = 0; while (cond) { __builtin_amdgcn_s_sleep(1); \
    if ((++_sp & 255u) == 0u) { if (xb_ld(&(bar)[XB_TMO])) break; if (_sp > XB_SPIN_CAP) { atomicAdd(&(bar)[XB_TMO], 1u); break; } } } } while (0)

struct XcdBarrier {
    unsigned* bar; unsigned x;
    volatile LAS unsigned* st;
};

__device__ __forceinline__ XcdBarrier xcd_barrier_post(unsigned* bar, volatile LAS unsigned* st) {
    XcdBarrier b; b.bar = bar; b.x = xb_xcc_id(); b.st = st;
    if (threadIdx.x == 0) (void)xb_add(&bar[XB_XCNT(b.x)], 1u);
    return b;
}
__device__ __forceinline__ void xcd_barrier_complete(unsigned* bar, unsigned x, unsigned& nloc, unsigned& nx) {
    const unsigned G = gridDim.x * gridDim.y * gridDim.z;
    unsigned sum, cnt, mine, sp = 0u;
    for (;;) {
        sum = 0u; cnt = 0u; mine = 0u;
#pragma unroll
        for (unsigned j = 0; j < 16; ++j) { const unsigned c = xb_ld(&bar[XB_XCNT(j)]); sum += c; cnt += (c > 0u) ? 1u : 0u; mine = (j == x) ? c : mine; }
        if (sum == G) break;
        __builtin_amdgcn_s_sleep(1);
        if ((++sp & 255u) == 0u) { if (xb_ld(&bar[XB_TMO])) break; if (sp > XB_SPIN_CAP) { atomicAdd(&bar[XB_TMO], 1u); break; } }
    }
    nloc = mine > 0u ? mine : 1u; nx = cnt > 0u ? cnt : 1u;
}

__device__ __forceinline__ void xcd_barrier(const XcdBarrier& b) {
    asm volatile("s_waitcnt vmcnt(0)" ::: "memory");
    __syncthreads();
    if (threadIdx.x == 0) {
        unsigned* bar = b.bar;
        __builtin_amdgcn_s_waitcnt(0);
        unsigned nloc = b.st[0], nx = b.st[1];
        if (nloc == 0u) { xcd_barrier_complete(bar, b.x, nloc, nx); b.st[0] = nloc; b.st[1] = nx; }
        const unsigned old = xb_add(&bar[XB_XSUB(b.x)], 1u);
        const unsigned gen = old / nloc;
        if (old + 1u == (gen + 1u) * nloc) {
            __builtin_amdgcn_fence(__ATOMIC_RELEASE, "agent");
            asm volatile("s_waitcnt vmcnt(0)" ::: "memory");
            const unsigned og = xb_add(&bar[XB_TOP], 1u);
            const unsigned tg = og / nx;
            if (og + 1u == (tg + 1u) * nx) xb_add(&bar[XB_TOPGEN], 1u);
            else XB_SPIN(xb_ld(&bar[XB_TOPGEN]) == tg, bar);
            __builtin_amdgcn_fence(__ATOMIC_ACQUIRE, "agent");
            xb_add(&bar[XB_XGEN(b.x)], 1u);
            asm volatile("s_waitcnt vmcnt(0)" ::: "memory");
        } else {
            XB_SPIN(xb_ld(&bar[XB_XGEN(b.x)]) == gen, bar);
            __builtin_amdgcn_fence(__ATOMIC_ACQUIRE, "agent");
            asm volatile("s_waitcnt vmcnt(0)" ::: "memory");
        }
    }
    __syncthreads();
}

#define DI __device__ __forceinline__
constexpr int NWAVES = 8;
constexpr int D = 1024, NPR = 16384, NSM = 1024, MTOK = NPR + NSM, NIN = 2320, NINP = 2560, FF = 4096, NADA = 6144;
constexpr int FFP = FF + 64;
constexpr int C_GQ = 0, C_GK = 256, C_GV = 512, C_GR = 1024, C_GLR = 1536, C_SQ = 1552, C_SK = 2064, C_SV = 2192;
constexpr float EPS = 1e-6f;
constexpr float LOG2E = 1.4426950408889634f;
constexpr int NPOS = 2056;
constexpr size_t O_Y = 0, O_STP = 17825792, O_CKP = O_STP + 262144, O_CVP = O_CKP + 131072, O_STS = O_CVP + 131072, O_CKS = O_STS + 4194304, O_CVS = O_CKS + 2097152, O_END = O_CVS + 2097152;
static_assert(O_END == 26738688, "output size");
constexpr size_t MiB = 1u << 20;
constexpr size_t WS_CTL = 0, CTL_ZERO_BYTES = 180224;
constexpr size_t WS_ROPE = 1 * MiB, WS_SC = 2 * MiB, WS_MOD = 3 * MiB, WS_WOUT = 9 * MiB, WS_W1 = 11 * MiB, WS_W2 = 19 * MiB, WS_WIN = 28 * MiB, WS_WADA = 33 * MiB;
constexpr size_t WS_XN = 45 * MiB, WS_PROJ = 79 * MiB, WS_U = 164 * MiB, WS_GD = 172 * MiB, WS_MIX = 173 * MiB, WS_HID = 79 * MiB, WS_HB = 218 * MiB, WS_END = 252 * MiB;
constexpr size_t WS_SLAB_ADA = 218 * MiB;
constexpr size_t WS_SLAB_OUT = 28 * MiB;
constexpr size_t WS_MIXS = 253 * MiB, WS_MIXS_V = WS_MIXS - (size_t)16384 * 1024 * 2;
constexpr size_t WS_SLAB_FF2 = 28 * MiB;
static_assert(WS_W2 + (size_t)D * FFP * 2 <= WS_WIN && WS_WIN + (size_t)NINP * D * 2 <= WS_WADA && WS_SLAB_OUT + (size_t)64 * 262144 <= WS_XN && WS_PROJ + (size_t)MTOK * NINP * 2 <= WS_U && WS_XN + (size_t)MTOK * D * 2 <= WS_PROJ && WS_MIX + (size_t)MTOK * D * 2 <= WS_HB && WS_HID + (size_t)MTOK * FFP * 2 <= WS_HB
              && WS_HB + (size_t)MTOK * D * 2 <= WS_END && WS_SLAB_FF2 + (size_t)64 * 262144 <= WS_XN, "d_ws map");
constexpr int CW_BAR = 4096, CW_CNTA = 24576, CW_CNTP = 32768, CW_CNTS = CW_CNTP + 68 * 64;
constexpr int CW_CNTX = CW_CNTS + 16 * 64, CW_CNTQ = CW_CNTX + 64 * 32;
constexpr int CW_CNTB = CW_CNTQ + 8 * 32;
constexpr int CW_CNTM = CW_CNTB + 32;
static_assert((size_t)(CW_CNTM + 64 * 32) * 4 <= CTL_ZERO_BYTES, "control words inside the zeroed region");
constexpr size_t WS_XS = 252 * MiB;
static_assert((size_t)(CW_CNTS + 16 * 64) * 4 <= CTL_ZERO_BYTES, "control words inside the zeroed region");
constexpr int RING_OFF = 0, RING_BYTES = 131072, LDSCTL_OFF = RING_BYTES, MISC_OFF = LDSCTL_OFF + 320, LDS_BYTES = 147456;

typedef short s16x4 __attribute__((ext_vector_type(4)));
typedef float f32x16 __attribute__((ext_vector_type(16)));
typedef short v4i16_t __attribute__((ext_vector_type(4)));
typedef unsigned u32x2 __attribute__((ext_vector_type(2)));

DI float bf2f(unsigned short b) { return __uint_as_float((unsigned)b << 16); }
DI float bfs2f(short b) { return __uint_as_float(((unsigned)(unsigned short)b) << 16); }
DI unsigned cvtpk(float lo, float hi) { return pg8::cvt_pk_bf16(lo, hi); }
DI float wave_sum(float v) {
#pragma unroll
    for (int o = 1; o < 64; o <<= 1) v += __shfl_xor(v, o);
    return v;
}
DI int crow(int r, int hi) { return (r & 3) + 8 * (r >> 2) + 4 * hi; }
DI s16x4 trrd(LAS const unsigned char* p) { return __builtin_bit_cast(s16x4, __builtin_amdgcn_ds_read_tr16_b64_v4i16((LAS v4i16_t*)p)); }
DI bf16x8 cat8(s16x4 lo, s16x4 hi) { return (bf16x8){lo[0], lo[1], lo[2], lo[3], hi[0], hi[1], hi[2], hi[3]}; }
DI float silu_f(float v) { return v * __builtin_amdgcn_rcpf(1.f + __expf(-v)); }
DI float logsig_f(float x) { return -(__builtin_fmaxf(-x, 0.f) + __logf(1.f + __expf(-__builtin_fabsf(x)))); }
DI int modrow(int m) { return m < NPR ? (m >> 11) : 8 + ((m - NPR) >> 3); }
DI unsigned kswz(int row, int c) { return (unsigned)(row * 128 + ((c ^ ((row >> 1) & 7)) << 4)); }

struct Frame {
    LAS unsigned char* lds;
    volatile LAS unsigned* MISC;
    gu32* ctl;
    int tid, lane, wave, vcu, G;
    const float* const* in;
    float* out; unsigned char* ws;
    const float* invf;
};
#define IN_XP 0
#define IN_XS 1
#define IN_STATE 2
#define IN_CK 3
#define IN_CV 4
#define IN_CP 5
#define IN_CS 6
#define IN_WADA 7
#define IN_BADA 8
#define IN_N1 9
#define IN_N2 10
#define IN_WIN 11
#define IN_WGU 12
#define IN_BG 13
#define IN_GNW 14
#define IN_QNW 15
#define IN_KNW 16
#define IN_SINK 17
#define IN_WOUT 18
#define IN_WFF1 19
#define IN_WFF2 20

#ifndef INSTR
#define INSTR 0
#endif
#define INSTR_BLOCK 0
#define INSTR_A1 4
#define INSTR_B1 5
#define INSTR_S1 0.01f
#define INSTR_A2 0
#define INSTR_B2 0
#define INSTR_S2 0.0001f
#if INSTR
#define TS(k) do { if ((int)blockIdx.x == INSTR_BLOCK && threadIdx.x == 0) ((unsigned long long*)(F.ws + WS_CTL + 8192))[k] = __builtin_amdgcn_s_memrealtime(); } while (0)
#else
#define TS(k) do { } while (0)
#endif
#if INSTR >= 2
#define TSI(k) TS(k)
#else
#define TSI(k) do { } while (0)
#endif
#if INSTR
#define GTS(p) (((int)blockIdx.x == INSTR_BLOCK && (p) == INSTR_GPHASE) ? (unsigned long long*)(args.ws + WS_CTL + 8192) : nullptr)
#else
#define GTS(p) nullptr
#endif
#define INSTR_GPHASE 8
struct ConvJob { const float* W; int K, N, nb0, nblk; bf16* WT; int ldt; };
template <int NB, bool WT = false>
DI void p0_transpose_batch(const ConvJob (&J)[NB], const int (&item)[NB], const bool (&on)[NB], LAS float* scr, int lane) {
    float tv[NB][32];
#pragma unroll
    for (int b = 0; b < NB; ++b) {
        const int kb = item[b] / J[b].nblk, nb = J[b].nb0 + item[b] % J[b].nblk, k0 = 64 * kb, n0 = 32 * nb; const int nn = n0 + 4 * (lane & 7); const bool ok = on[b] && nn < J[b].N;
#pragma unroll
        for (int i = 0; i < 8; ++i) { const int kk = 8 * i + (lane >> 3);
            const f32x4 v = ok ? __builtin_nontemporal_load((const GAS f32x4*)(J[b].W + (size_t)(k0 + kk) * J[b].N + nn)) : (f32x4){0.f, 0.f, 0.f, 0.f};
            tv[b][4 * i] = v.x; tv[b][4 * i + 1] = v.y; tv[b][4 * i + 2] = v.z; tv[b][4 * i + 3] = v.w; }
    }
#pragma unroll
    for (int b = 0; b < NB; ++b) {
        if (on[b]) {
            const int kb = item[b] / J[b].nblk, nb = J[b].nb0 + item[b] % J[b].nblk, k0 = 64 * kb, n0 = 32 * nb;
#pragma unroll
            for (int i = 0; i < 8; ++i) { const int kk = 8 * i + (lane >> 3);
#pragma unroll
                for (int e = 0; e < 4; ++e) scr[kk * 33 + 4 * (lane & 7) + e] = tv[b][4 * i + e]; }
            LDS_WAIT(); asm volatile("" ::: "memory");
            const int c = lane & 7;
#pragma unroll
            for (int j = 0; j < 4; ++j) { const int n = (lane >> 3) + 8 * j; const LAS float* s = scr + (8 * c) * 33 + n;
                v4u o; o.x = cvtpk(s[0 * 33], s[1 * 33]); o.y = cvtpk(s[2 * 33], s[3 * 33]); o.z = cvtpk(s[4 * 33], s[5 * 33]); o.w = cvtpk(s[6 * 33], s[7 * 33]);
                if (WT) pg8::wt_store16(__builtin_amdgcn_make_buffer_rsrc((void*)J[b].WT, 0, 64 << 20, 0x00020000), (unsigned)(((size_t)(n0 + n) * J[b].ldt + k0 + 8 * c) * 2), o);
                else *(GAS v4u*)(J[b].WT + (size_t)(n0 + n) * J[b].ldt + k0 + 8 * c) = o; }
            LDS_WAIT(); asm volatile("" ::: "memory");
        }
    }
}
DI void conv_set(Frame& F, int set, int wk, int nwk, int trip0 = 0, int trip1 = 1 << 20) {
    LAS float* scr = (LAS float*)(F.lds + RING_OFF + F.wave * 16384);
    bf16* Win_t = (bf16*)(F.ws + WS_WIN); bf16* Wout_t = (bf16*)(F.ws + WS_WOUT); bf16* W1_t = (bf16*)(F.ws + WS_W1); bf16* W2_t = (bf16*)(F.ws + WS_W2); bf16* Wada_t = (bf16*)(F.ws + WS_WADA);
    constexpr int I_ADA = (D / 64) * (NADA / 32), I_IN = (D / 64) * (NINP / 32), I_OUT = (D / 64) * (D / 32), I_1 = (D / 64) * (FF / 32), I_2 = (FF / 64) * (D / 32);
    const ConvJob jAda{F.in[IN_WADA], D, NADA, 0, NADA / 32, Wada_t, D}, jIn{F.in[IN_WIN], D, NIN, 0, NINP / 32, Win_t, D}, jOut{F.in[IN_WOUT], D, D, 0, D / 32, Wout_t, D},
                  j1{F.in[IN_WFF1], D, FF, 0, FF / 32, W1_t, D}, j2{F.in[IN_WFF2], FF, D, 0, D / 32, W2_t, FFP};
    const int total = set == 1 ? I_ADA + I_IN : I_OUT + I_1 + I_2;
#pragma unroll 1
    for (int t = trip0; t < trip1 && wk + 2 * t * nwk < total; ++t) {
        const int it0 = wk + 2 * t * nwk;
        ConvJob J[2]; int item[2]; bool on[2];
#pragma unroll
        for (int b = 0; b < 2; ++b) { const int it = it0 + b * nwk; on[b] = it < total; const int tt = on[b] ? it : 0;
            if (set == 1) { const bool a = tt < I_ADA; J[b] = a ? jAda : jIn; item[b] = a ? tt : tt - I_ADA; }
            else { const bool a = tt < I_OUT, c = tt < I_OUT + I_1; J[b] = a ? jOut : (c ? j1 : j2); item[b] = a ? tt : (c ? tt - I_OUT : tt - I_OUT - I_1); } }
        if (set == 1) p0_transpose_batch<2, true>(J, item, on, scr, F.lane); else p0_transpose_batch<2, false>(J, item, on, scr, F.lane);
    }
}
DI void front_ada_slice(Frame& F, int c) {
    const int ks = c & 3;
    bf16* SC = (bf16*)(F.ws + WS_SC);
    {   f32x4 cv[17];
#pragma unroll
        for (int i = 0; i < 17; ++i) { const int r = F.wave + 8 * i; const float* src = i == 0 ? F.in[IN_CP] + (size_t)r * D : F.in[IN_CS] + (size_t)(r - 8) * D; cv[i] = *((const GAS f32x4*)(src + 256 * ks) + F.lane); }
#pragma unroll
        for (int i = 0; i < 17; ++i) { const int r = F.wave + 8 * i; const f32x4 v = cv[i];
            *((GAS unsigned long long*)(SC + (size_t)r * D + 256 * ks) + F.lane) = (unsigned long long)cvtpk(silu_f(v.x), silu_f(v.y)) | ((unsigned long long)cvtpk(silu_f(v.z), silu_f(v.w)) << 32); }
    }
    asm volatile("s_waitcnt vmcnt(0)" ::: "memory");
    __syncthreads();
}
DI void front_rope(Frame& F, int wk, int nwk) {
    float* ROPE = (float*)(F.ws + WS_ROPE);
    float invj = 0.f;
#pragma unroll
    for (int jj = 0; jj < 32; ++jj) invj = ((F.lane & 31) == jj) ? F.invf[jj] : invj;
    for (int idx = wk * 64 + F.lane; idx < NPOS * 32; idx += nwk * 64) {
        const int pi = idx >> 5, j = idx & 31; const int pos = pi < 2048 ? pi : 8192 + (pi - 2048);
        const float angf = (float)pos * invj;
        const double a = (double)angf; const double n = __builtin_rint(a * 0.63661977236758134308); const double rr = a - n * 1.57079632679489661923;
        const float x = (float)rr, x2 = x * x;
        const float s = x + x * x2 * (-1.6666654611e-1f + x2 * (8.3321608736e-3f + x2 * (-1.9515295891e-4f)));
        const float c = 1.f - 0.5f * x2 + x2 * x2 * (4.166664568298827e-2f + x2 * (-1.388731625493765e-3f + x2 * 2.443315711809948e-5f));
        const int q = ((int)n) & 3;
        const float sn = (q == 0) ? s : (q == 1) ? c : (q == 2) ? -s : -c;
        const float cs = (q == 0) ? c : (q == 1) ? -s : (q == 2) ? -c : s;
        ROPE[(size_t)pi * 64 + j] = cs; ROPE[(size_t)pi * 64 + 32 + j] = sn;
    }
}

constexpr int NADAWG = 96;
DI void ada_combine(Frame& F, int t) {
    float* MOD = (float*)(F.ws + WS_MOD); const float* SLA = (const float*)(F.ws + WS_SLAB_ADA); const float* bada = F.in[IN_BADA];
    const int c4 = F.tid & 63; const f32x4 bv = *((const GAS f32x4*)(bada + 256 * t) + c4);
#pragma unroll 1
    for (int r0 = 0; r0 < 136; r0 += 32) {
        f32x4 a[4][4];
#pragma unroll
        for (int e = 0; e < 4; ++e) { const int r = r0 + 8 * e + (F.tid >> 6); const int rr = r < 136 ? r : 135;
#pragma unroll
            for (int ks = 0; ks < 4; ++ks) a[e][ks] = *((const GAS f32x4*)(SLA + (size_t)(4 * t + ks) * 65536 + (size_t)rr * 256) + c4); }
#pragma unroll
        for (int e = 0; e < 4; ++e) { const int r = r0 + 8 * e + (F.tid >> 6);
            if (r < 136) *((GAS f32x4*)(MOD + (size_t)r * NADA + 256 * t) + c4) = bv + ((a[e][0] + a[e][1]) + (a[e][2] + a[e][3])); }
    }
}

template <bool SECOND>
DI void nm_stage_mod(Frame& F, int mr_p, int mr_s, int set = 0) {
    const float* nw = SECOND ? F.in[IN_N2] : F.in[IN_N1]; const float* MOD = (const float*)(F.ws + WS_MOD); const float* bada = F.in[IN_BADA]; const float* SLA = (const float*)(F.ws + WS_SLAB_ADA);
    LAS float* L = (LAS float*)(F.lds + RING_OFF) + set * 4096;
    const int which = F.tid >> 8, c4 = F.tid & 255; const int mr = which ? mr_s : mr_p; const int j = c4 >> 6, l4 = c4 & 63;
    f32x4 sh, sc; const f32x4 wn = *((const GAS f32x4*)nw + c4);
    if (SECOND) { sh = *((const GAS f32x4*)(MOD + (size_t)mr * NADA + 3072) + c4); sc = *((const GAS f32x4*)(MOD + (size_t)mr * NADA + 4096) + c4); }
    else { sh = *((const GAS f32x4*)bada + c4); sc = *((const GAS f32x4*)(bada + 1024) + c4);
#pragma unroll
        for (int ks = 0; ks < 4; ++ks) { sh += *(const GAS f32x4*)(SLA + (size_t)(4 * j + ks) * 65536 + (size_t)mr * 256 + 4 * l4); sc += *(const GAS f32x4*)(SLA + (size_t)(4 * (4 + j) + ks) * 65536 + (size_t)mr * 256 + 4 * l4); } }
    *(LAS f32x4*)(L + which * 2048 + 4 * c4) = sh; *(LAS f32x4*)(L + which * 2048 + 1024 + 4 * c4) = (sc + 1.f) * wn;
}
DI void nm_read_mod(Frame& F, int which, f32x4 (&sh)[4], f32x4 (&sc)[4]) {
    LAS const float* L = (LAS const float*)(F.lds + RING_OFF) + which * 2048;
#pragma unroll
    for (int j = 0; j < 4; ++j) { sh[j] = *(LAS const f32x4*)(L + 4 * (F.lane + 64 * j)); sc[j] = *(LAS const f32x4*)(L + 1024 + 4 * (F.lane + 64 * j)); }
}
template <bool SECOND>
DI void nm_load_row(Frame& F, int m, f32x4 (&v)[4]) {
    if (SECOND) { const bf16* HB = (const bf16*)(F.ws + WS_HB);
#pragma unroll
        for (int j = 0; j < 4; ++j) { const u32x2 hw = __builtin_nontemporal_load((const GAS u32x2*)(HB + (size_t)m * D) + F.lane + 64 * j);
            v[j] = (f32x4){__uint_as_float(hw.x << 16), __uint_as_float(hw.x & 0xffff0000u), __uint_as_float(hw.y << 16), __uint_as_float(hw.y & 0xffff0000u)}; } }
    else { const float* src = m < NPR ? F.in[IN_XP] + (size_t)m * D : F.in[IN_XS] + (size_t)(m - NPR) * D;
#pragma unroll
        for (int j = 0; j < 4; ++j) v[j] = __builtin_nontemporal_load((const GAS f32x4*)src + F.lane + 64 * j); }
}
DI void nm_finish_row(Frame& F, int m, const f32x4 (&v)[4], const f32x4 (&sh)[4], const f32x4 (&sc)[4]) {
    float s = 0.f;
#pragma unroll
    for (int j = 0; j < 4; ++j) s += (v[j].x * v[j].x + v[j].y * v[j].y) + (v[j].z * v[j].z + v[j].w * v[j].w);
    const float rstd = __builtin_amdgcn_rsqf(wave_sum(s) * (1.f / D) + EPS);
    GAS unsigned long long* o8 = (GAS unsigned long long*)((bf16*)(F.ws + WS_XN) + (size_t)m * D) + F.lane;
#pragma unroll
    for (int j = 0; j < 4; ++j) { const f32x4 o = v[j] * rstd * sc[j] + sh[j];
        o8[64 * j] = (unsigned long long)cvtpk(o.x, o.y) | ((unsigned long long)cvtpk(o.z, o.w) << 32); }
}
DI void prenorm_rows(Frame& F, int wk, int nwk) {
    bf16* XN = (bf16*)(F.ws + WS_XN);
#pragma unroll 1
    for (int m0 = wk; m0 < MTOK; m0 += 4 * nwk) {
        f32x4 v[4][4];
#pragma unroll
        for (int rr = 0; rr < 4; ++rr) { const int m = m0 + rr * nwk; nm_load_row<false>(F, m < MTOK ? m : m0, v[rr]); }
#pragma unroll
        for (int rr = 0; rr < 4; ++rr) {
            const int m = m0 + rr * nwk; float s = 0.f;
#pragma unroll
            for (int j = 0; j < 4; ++j) s += (v[rr][j].x * v[rr][j].x + v[rr][j].y * v[rr][j].y) + (v[rr][j].z * v[rr][j].z + v[rr][j].w * v[rr][j].w);
            const float rstd = __builtin_amdgcn_rsqf(wave_sum(s) * (1.f / D) + EPS);
            if (m < MTOK) { GAS unsigned long long* o8 = (GAS unsigned long long*)(XN + (size_t)m * D) + F.lane;
#pragma unroll
                for (int j = 0; j < 4; ++j) { const f32x4 o = v[rr][j] * rstd; o8[64 * j] = (unsigned long long)cvtpk(o.x, o.y) | ((unsigned long long)cvtpk(o.z, o.w) << 32); } }
        }
    }
}
DI void nm_apply_row(Frame& F, int m, const f32x4 (&sh)[4], const f32x4 (&sc)[4]) {
    GAS unsigned long long* p8 = (GAS unsigned long long*)((bf16*)(F.ws + WS_XN) + (size_t)m * D) + F.lane;
    unsigned long long w[4];
#pragma unroll
    for (int j = 0; j < 4; ++j) w[j] = p8[64 * j];
#pragma unroll
    for (int j = 0; j < 4; ++j) { const unsigned lo = (unsigned)w[j], hi = (unsigned)(w[j] >> 32);
        const f32x4 v = (f32x4){__uint_as_float(lo << 16), __uint_as_float(lo & 0xffff0000u), __uint_as_float(hi << 16), __uint_as_float(hi & 0xffff0000u)};
        const f32x4 o = v * sc[j] + sh[j];
        p8[64 * j] = (unsigned long long)cvtpk(o.x, o.y) | ((unsigned long long)cvtpk(o.z, o.w) << 32); }
}
DI void norm1_apply_phase(Frame& F) {
    const int wg = F.vcu; const int wv = wg * NWAVES + F.wave; const int m0 = 8 * wv; const bool has_s = wv < 1024; const int ms = NPR + wv;
    nm_stage_mod<false>(F, modrow(64 * wg), modrow(NPR + 8 * (wg < 128 ? wg : 0)));
    __syncthreads();
    f32x4 sh[4], sc[4];
    nm_read_mod(F, 0, sh, sc);
#pragma unroll 4
    for (int r = 0; r < 8; ++r) nm_apply_row(F, m0 + r, sh, sc);
    if (has_s) { nm_read_mod(F, 1, sh, sc); nm_apply_row(F, ms, sh, sc); }
    __syncthreads();
}
DI void nm_store_row(Frame& F, int m, const f32x4 (&v)[4], float rstd, const f32x4 (&sh)[4], const f32x4 (&sc)[4]) {
    GAS unsigned long long* o8 = (GAS unsigned long long*)((bf16*)(F.ws + WS_XN) + (size_t)m * D) + F.lane;
#pragma unroll
    for (int j = 0; j < 4; ++j) { const f32x4 o = v[j] * rstd * sc[j] + sh[j];
        o8[64 * j] = (unsigned long long)cvtpk(o.x, o.y) | ((unsigned long long)cvtpk(o.z, o.w) << 32); }
}
DI float nm_rstd(const f32x4 (&v)[4]) {
    float s = 0.f;
#pragma unroll
    for (int j = 0; j < 4; ++j) s += (v[j].x * v[j].x + v[j].y * v[j].y) + (v[j].z * v[j].z + v[j].w * v[j].w);
    return __builtin_amdgcn_rsqf(wave_sum(s) * (1.f / D) + EPS);
}
DI void nm_store_pre(Frame& F, int m, const f32x4 (&v)[4], float rstd) {
    GAS unsigned long long* o8 = (GAS unsigned long long*)((bf16*)(F.ws + WS_XN) + (size_t)m * D) + F.lane;
#pragma unroll
    for (int j = 0; j < 4; ++j) { const f32x4 o = v[j] * rstd; o8[64 * j] = (unsigned long long)cvtpk(o.x, o.y) | ((unsigned long long)cvtpk(o.z, o.w) << 32); }
}
DI int nm_third_row(int pv, int k, int q, bool& is_s, bool& ok) {
    is_s = (k == 2) && q >= 16; ok = !is_s || pv < 128;
    return is_s ? NPR + 8 * pv + (q - 16) : 64 * pv + 24 * k + q;
}
DI void norm1_merged(Frame& F, const unsigned* cntb) {
    const int bx = (int)blockIdx.x;
    if (bx < NADAWG) return;
    const int wg = F.vcu; const int wv = wg * NWAVES + F.wave;
    const int m0 = 8 * wv; const bool has_s = wv < 1024; const int ms = NPR + wv;
    const int idx = bx - NADAWG; constexpr int NTH = 3 * NADAWG, NW = 256 - NADAWG;
    const int nth = idx + NW < NTH ? 2 : 1;
    f32x4 va[8][4], vs[4], sh[4], sc[4]; float rs[8], rss = 0.f;
#pragma unroll
    for (int r = 0; r < 8; ++r) nm_load_row<false>(F, m0 + r, va[r]);
    if (has_s) nm_load_row<false>(F, ms, vs);
#pragma unroll
    for (int r = 0; r < 8; ++r) rs[r] = nm_rstd(va[r]);
    if (has_s) rss = nm_rstd(vs);
#pragma unroll 1
    for (int s3 = 0; s3 < nth; ++s3) {
        const int t = idx + NW * s3, g = t / 3, k = t - 3 * g; const int pv = (g % 8) * (F.G / 8) + g / 8;
        f32x4 v[3][4]; int mm[3]; bool ok[3];
#pragma unroll
        for (int e = 0; e < 3; ++e) { bool is_s; mm[e] = nm_third_row(pv, k, 3 * F.wave + e, is_s, ok[e]); nm_load_row<false>(F, ok[e] ? mm[e] : m0, v[e]); }
#pragma unroll
        for (int e = 0; e < 3; ++e) { const float q = nm_rstd(v[e]); if (ok[e]) nm_store_pre(F, mm[e], v[e], q); }
    }
    pg8::cnt_wait(cntb, 32u);
    nm_stage_mod<false>(F, modrow(64 * wg), modrow(NPR + 8 * (wg < 128 ? wg : 0)));
#pragma unroll 1
    for (int s3 = 0; s3 < nth; ++s3) { const int t = idx + NW * s3, g = t / 3; const int pv = (g % 8) * (F.G / 8) + g / 8;
        nm_stage_mod<false>(F, modrow(64 * pv), modrow(NPR + 8 * (pv < 128 ? pv : 0)), 1 + s3); }
    __syncthreads();
    nm_read_mod(F, 0, sh, sc);
#pragma unroll
    for (int r = 0; r < 8; ++r) nm_store_row(F, m0 + r, va[r], rs[r], sh, sc);
    if (has_s) { nm_read_mod(F, 1, sh, sc); nm_store_row(F, ms, vs, rss, sh, sc); }
#pragma unroll 1
    for (int s3 = 0; s3 < nth; ++s3) {
        const int t = idx + NW * s3, g = t / 3, k = t - 3 * g; const int pv = (g % 8) * (F.G / 8) + g / 8;
        unsigned long long w[3][4]; int mm[3]; bool is_s[3], ok[3];
#pragma unroll
        for (int e = 0; e < 3; ++e) { mm[e] = nm_third_row(pv, k, 3 * F.wave + e, is_s[e], ok[e]);
            const GAS unsigned long long* p8 = (const GAS unsigned long long*)((const bf16*)(F.ws + WS_XN) + (size_t)(ok[e] ? mm[e] : m0) * D) + F.lane;
#pragma unroll
            for (int j = 0; j < 4; ++j) w[e][j] = p8[64 * j]; }
#pragma unroll
        for (int e = 0; e < 3; ++e) {
            nm_read_mod(F, 2 * (1 + s3) + (is_s[e] ? 1 : 0), sh, sc);
            if (ok[e]) { GAS unsigned long long* p8 = (GAS unsigned long long*)((bf16*)(F.ws + WS_XN) + (size_t)mm[e] * D) + F.lane;
#pragma unroll
                for (int j = 0; j < 4; ++j) { const unsigned lo = (unsigned)w[e][j], hi = (unsigned)(w[e][j] >> 32);
                    const f32x4 v = (f32x4){__uint_as_float(lo << 16), __uint_as_float(lo & 0xffff0000u), __uint_as_float(hi << 16), __uint_as_float(hi & 0xffff0000u)};
                    const f32x4 o = v * sc[j] + sh[j];
                    p8[64 * j] = (unsigned long long)cvtpk(o.x, o.y) | ((unsigned long long)cvtpk(o.z, o.w) << 32); } }
        }
    }
    __syncthreads();
}
template <bool SECOND>
DI void normmod_phase(Frame& F) {
    const float* MOD = (const float*)(F.ws + WS_MOD); const float* SLO = (const float*)(F.ws + WS_SLAB_OUT); bf16* HB = (bf16*)(F.ws + WS_HB);
    { const int wg = F.vcu;
        const int wv = wg * NWAVES + F.wave;
        const int m0 = 8 * wv; const bool has_s = wv < 1024; const int ms = NPR + wv;
        f32x4 va[4][4], vs[4], sh[4], sc[4];
#pragma unroll
        for (int r = 0; r < 4; ++r) nm_load_row<SECOND>(F, m0 + r, va[r]);
        nm_stage_mod<SECOND>(F, modrow(64 * wg), modrow(NPR + 8 * (wg < 128 ? wg : 0)));
        __syncthreads();
        nm_read_mod(F, 0, sh, sc);
#pragma unroll
        for (int r = 0; r < 4; ++r) nm_finish_row(F, m0 + r, va[r], sh, sc);
#pragma unroll
        for (int r = 0; r < 4; ++r) nm_load_row<SECOND>(F, m0 + 4 + r, va[r]);
        if (has_s) nm_load_row<false>(F, ms, vs);
#pragma unroll
        for (int r = 0; r < 4; ++r) nm_finish_row(F, m0 + 4 + r, va[r], sh, sc);
        if (has_s) {
            const int mr = modrow(ms);
            nm_read_mod(F, 1, sh, sc);
            if (SECOND) {
                const float* SL = SLO + (size_t)(((ms - NPR) >> 8) * 16) * 65536 + (size_t)(ms & 255) * 256 + 4 * F.lane;
                const GAS f32x4* g1r = (const GAS f32x4*)(MOD + (size_t)mr * NADA + 2048) + F.lane;
#pragma unroll
                for (int j = 0; j < 4; ++j) { f32x4 a = *(const GAS f32x4*)(SL + (size_t)(4 * j) * 65536);
#pragma unroll
                    for (int ks = 1; ks < 4; ++ks) a += *(const GAS f32x4*)(SL + (size_t)(4 * j + ks) * 65536);
                    vs[j] = vs[j] + g1r[64 * j] * a;
                    *((GAS u32x2*)(HB + (size_t)ms * D) + F.lane + 64 * j) = (u32x2){cvtpk(vs[j].x, vs[j].y), cvtpk(vs[j].z, vs[j].w)}; }
            }
            nm_finish_row(F, ms, vs, sh, sc);
        }
        __syncthreads();
    }
}

DI void norm2_sample(Frame& F, int q, const unsigned* cntq, unsigned* cntr) {
    const float* MOD = (const float*)(F.ws + WS_MOD); const float* SLO = (const float*)(F.ws + WS_SLAB_OUT);
    const int p = q >> 4;
    const int ms0 = NPR + 16 * q + 2 * F.wave;
    const int mrA = modrow(NPR + 16 * q), mrB = mrA + 1; const int which = F.wave >> 2; const int mr = which ? mrB : mrA;
    f32x4 vs[2][4], sh[4], sc[4];
#pragma unroll
    for (int e = 0; e < 2; ++e) nm_load_row<false>(F, ms0 + e, vs[e]);
    nm_stage_mod<true>(F, mrA, mrB);
    __syncthreads();
    TS(41);
    pg8::cnt_wait(cntq + 32 * p, 128u);
    TS(42);
    nm_read_mod(F, which, sh, sc);
    const __amdgpu_buffer_rsrc_t rsH = __builtin_amdgcn_make_buffer_rsrc((void*)(F.ws + WS_HB), 0, MTOK * D * 2, 0x00020000), rsX = __builtin_amdgcn_make_buffer_rsrc((void*)(F.ws + WS_XN), 0, MTOK * D * 2, 0x00020000);
    const GAS f32x4* g1r = (const GAS f32x4*)(MOD + (size_t)mr * NADA + 2048) + F.lane;
#pragma unroll
    for (int e = 0; e < 2; ++e) { const int ms = ms0 + e;
        const float* SL = SLO + (size_t)(p * 16) * 65536 + (size_t)(ms & 255) * 256 + 4 * F.lane;
        float s = 0.f;
#pragma unroll
        for (int j = 0; j < 4; ++j) { const f32x4 a = (*(const GAS f32x4*)(SL + (size_t)(4 * j) * 65536) + *(const GAS f32x4*)(SL + (size_t)(4 * j + 1) * 65536))
                                                      + (*(const GAS f32x4*)(SL + (size_t)(4 * j + 2) * 65536) + *(const GAS f32x4*)(SL + (size_t)(4 * j + 3) * 65536));
            vs[e][j] = vs[e][j] + g1r[64 * j] * a;
            __builtin_amdgcn_raw_buffer_store_b64((u32x2){cvtpk(vs[e][j].x, vs[e][j].y), cvtpk(vs[e][j].z, vs[e][j].w)}, rsH, (int)(((size_t)ms * D + 4 * (F.lane + 64 * j)) * 2), 0, 16);
            s += (vs[e][j].x * vs[e][j].x + vs[e][j].y * vs[e][j].y) + (vs[e][j].z * vs[e][j].z + vs[e][j].w * vs[e][j].w); }
        const float rstd = __builtin_amdgcn_rsqf(wave_sum(s) * (1.f / D) + EPS);
#pragma unroll
        for (int j = 0; j < 4; ++j) { const f32x4 o = vs[e][j] * rstd * sc[j] + sh[j];
            __builtin_amdgcn_raw_buffer_store_b64((u32x2){cvtpk(o.x, o.y), cvtpk(o.z, o.w)}, rsX, (int)(((size_t)ms * D + 4 * (F.lane + 64 * j)) * 2), 0, 16); }
    }
    pg8::cnt_arrive(cntr + 32 * p);
    __syncthreads();
}

DI void swa_tile(const bf16x8 (&qf)[4], LAS const unsigned char* Ks, LAS const unsigned char* Vs, LAS float* stg, int kt0, int ktmin, int thr, float sink2, float (&ov)[32], int lane) {
    const int r = lane & 31, h = lane >> 5;
    f32x16 p[5];
#pragma unroll
    for (int kt = 0; kt < 5; ++kt) {
        f32x16 acc;
        if (kt0 + kt >= ktmin) {
#pragma unroll
            for (int i = 0; i < 16; ++i) acc[i] = 0.f;
            const int key = 32 * (kt0 + kt) + r;
#pragma unroll
            for (int s = 0; s < 4; ++s) { const bf16x8 a = *(LAS const bf16x8*)(Ks + kswz(key, 2 * s + h)); acc = __builtin_amdgcn_mfma_f32_32x32x16_bf16(a, qf[s], acc, 0, 0, 0); }
            if (kt == 0) {
#pragma unroll
                for (int i = 0; i < 16; ++i) acc[i] = (crow(i, h) > thr) ? acc[i] : -INFINITY; }
            if (kt == 4) {
#pragma unroll
                for (int i = 0; i < 16; ++i) acc[i] = (crow(i, h) <= thr) ? acc[i] : -INFINITY; }
        } else {
#pragma unroll
            for (int i = 0; i < 16; ++i) acc[i] = -INFINITY; }
        p[kt] = acc;
    }
    float mx = sink2;
#pragma unroll
    for (int kt = 0; kt < 5; ++kt)
#pragma unroll
        for (int i = 0; i < 16; ++i) mx = __builtin_fmaxf(mx, p[kt][i]);
    mx = __builtin_fmaxf(mx, __shfl_xor(mx, 32));
    float l = 0.f;
#pragma unroll
    for (int kt = 0; kt < 5; ++kt)
#pragma unroll
        for (int i = 0; i < 16; ++i) { const float e = __builtin_amdgcn_exp2f(p[kt][i] - mx); p[kt][i] = e; l += e; }
    l += __shfl_xor(l, 32); l += __builtin_amdgcn_exp2f(sink2 - mx);
    f32x16 o[2];
#pragma unroll
    for (int i = 0; i < 16; ++i) { o[0][i] = 0.f; o[1][i] = 0.f; }
    const int q4 = (lane & 15) >> 2, p4 = lane & 3, blk = (lane >> 4) & 1;
#pragma unroll
    for (int kt = 0; kt < 5; ++kt) {
        if (kt0 + kt >= ktmin) {
#pragma unroll
            for (int s2 = 0; s2 < 2; ++s2) {
                v4u w; w.x = cvtpk(p[kt][8 * s2 + 0], p[kt][8 * s2 + 1]); w.y = cvtpk(p[kt][8 * s2 + 2], p[kt][8 * s2 + 3]); w.z = cvtpk(p[kt][8 * s2 + 4], p[kt][8 * s2 + 5]); w.w = cvtpk(p[kt][8 * s2 + 6], p[kt][8 * s2 + 7]);
                const bf16x8 pa = __builtin_bit_cast(bf16x8, w);
                const int krow0 = 32 * (kt0 + kt) + 16 * s2 + 4 * h + q4;
#pragma unroll
                for (int dh = 0; dh < 2; ++dh) {
                    LAS const unsigned char* a0 = Vs + krow0 * 128 + (32 * dh + 16 * blk + 4 * p4) * 2;
                    const s16x4 lo = trrd(a0), hi = trrd(a0 + 8 * 128);
                    o[dh] = __builtin_amdgcn_mfma_f32_32x32x16_bf16(pa, cat8(lo, hi), o[dh], 0, 0, 0);
                }
            }
        }
    }
#pragma unroll
    for (int dh = 0; dh < 2; ++dh)
#pragma unroll
        for (int i = 0; i < 16; ++i) { const int q = crow(i, h), dd = 32 * dh + r; stg[q * 64 + (((dd >> 2) ^ (q & 15)) << 2) + (dd & 3)] = o[dh][i]; }
    asm volatile("s_waitcnt lgkmcnt(0)" ::: "memory");
    const int row = lane >> 1, half = lane & 1; const float rl = 1.f / __shfl(l, row);
#pragma unroll
    for (int k = 0; k < 8; ++k) { const f32x4 x = *(LAS const f32x4*)(stg + row * 64 + (((8 * half + k) ^ (row & 15)) << 2));
        ov[4 * k] = x.x * rl; ov[4 * k + 1] = x.y * rl; ov[4 * k + 2] = x.z * rl; ov[4 * k + 3] = x.w * rl; }
    asm volatile("s_waitcnt lgkmcnt(0)" ::: "memory");
}
DI void swa_store_row(bf16* op, const float (&ov)[32]) {
#pragma unroll
    for (int k = 0; k < 4; ++k) { v4u w; w.x = cvtpk(ov[8 * k], ov[8 * k + 1]); w.y = cvtpk(ov[8 * k + 2], ov[8 * k + 3]); w.z = cvtpk(ov[8 * k + 4], ov[8 * k + 5]); w.w = cvtpk(ov[8 * k + 6], ov[8 * k + 7]);
        *(GAS v4u*)(op + 8 * k) = w; }
}
struct QRegs { v4u x[4]; f32x4 cs[4], sn[4]; };
DI void qf_load(QRegs& R, const bf16* qrow, const float* rope_row, int h) {
#pragma unroll
    for (int s = 0; s < 4; ++s) R.x[s] = *(const GAS v4u*)(qrow + 16 * s + 8 * h);
#pragma unroll
    for (int s = 0; s < 2; ++s) { R.cs[2 * s] = *(const GAS f32x4*)(rope_row + 16 * s + 8 * h); R.cs[2 * s + 1] = *(const GAS f32x4*)(rope_row + 16 * s + 8 * h + 4);
        R.sn[2 * s] = *(const GAS f32x4*)(rope_row + 32 + 16 * s + 8 * h); R.sn[2 * s + 1] = *(const GAS f32x4*)(rope_row + 32 + 16 * s + 8 * h + 4); }
}
DI void qf_make(bf16x8 (&qf)[4], const QRegs& R, const f32x4 (&qw)[8]) {
    float x[4][8]; float ss = 0.f;
#pragma unroll
    for (int s = 0; s < 4; ++s) { const bf16x8 v = __builtin_bit_cast(bf16x8, R.x[s]);
#pragma unroll
        for (int j = 0; j < 8; ++j) { x[s][j] = bfs2f(v[j]); ss += x[s][j] * x[s][j]; } }
    ss += __shfl_xor(ss, 32);
    const float rstd = __builtin_amdgcn_rsqf(ss * (1.f / 64.f) + EPS);
#pragma unroll
    for (int s = 0; s < 4; ++s)
#pragma unroll
        for (int j = 0; j < 8; ++j) x[s][j] *= rstd * qw[2 * s + (j >> 2)][j & 3];
    constexpr float QS = 0.125f * LOG2E;
#pragma unroll
    for (int s = 0; s < 2; ++s)
#pragma unroll
        for (int j = 0; j < 8; ++j) { const float c = R.cs[2 * s + (j >> 2)][j & 3], sn = R.sn[2 * s + (j >> 2)][j & 3]; const float a = x[s][j], b = x[s + 2][j];
            x[s][j] = (a * c - b * sn) * QS; x[s + 2][j] = (b * c + a * sn) * QS; }
#pragma unroll
    for (int s = 0; s < 4; ++s) { v4u w; w.x = cvtpk(x[s][0], x[s][1]); w.y = cvtpk(x[s][2], x[s][3]); w.z = cvtpk(x[s][4], x[s][5]); w.w = cvtpk(x[s][6], x[s][7]); qf[s] = __builtin_bit_cast(bf16x8, w); }
}
struct KRegs { v4u a, b; f32x4 c0, c1, s0, s1; };
DI void kt_load(KRegs& R, const bf16* krow, const float* rope_row, int jq) {
    R.a = (v4u){0u, 0u, 0u, 0u}; R.b = R.a;
    if (krow) { R.a = *(const GAS v4u*)(krow + 8 * jq); R.b = *(const GAS v4u*)(krow + 32 + 8 * jq); }
    R.c0 = *(const GAS f32x4*)(rope_row + 8 * jq); R.c1 = *(const GAS f32x4*)(rope_row + 8 * jq + 4); R.s0 = *(const GAS f32x4*)(rope_row + 32 + 8 * jq); R.s1 = *(const GAS f32x4*)(rope_row + 32 + 8 * jq + 4);
}
DI void kt_finish(LAS unsigned char* Ks, int key, int jq, const KRegs& R, const f32x4 (&kw)[4], float* cache_out) {
    float x1[8], x2[8]; float ss = 0.f;
    const bf16x8 v1 = __builtin_bit_cast(bf16x8, R.a), v2 = __builtin_bit_cast(bf16x8, R.b);
#pragma unroll
    for (int e = 0; e < 8; ++e) { x1[e] = bfs2f(v1[e]); x2[e] = bfs2f(v2[e]); ss += x1[e] * x1[e] + x2[e] * x2[e]; }
    ss += __shfl_xor(ss, 1); ss += __shfl_xor(ss, 2);
    const float rstd = __builtin_amdgcn_rsqf(ss * (1.f / 64.f) + EPS);
    float o1[8], o2[8];
#pragma unroll
    for (int e = 0; e < 8; ++e) { const float a = x1[e] * rstd * kw[e >> 2][e & 3], b = x2[e] * rstd * kw[2 + (e >> 2)][e & 3]; const float c = (e < 4 ? R.c0 : R.c1)[e & 3], sn = (e < 4 ? R.s0 : R.s1)[e & 3];
        o1[e] = a * c - b * sn; o2[e] = b * c + a * sn; }
    v4u w1, w2; w1.x = cvtpk(o1[0], o1[1]); w1.y = cvtpk(o1[2], o1[3]); w1.z = cvtpk(o1[4], o1[5]); w1.w = cvtpk(o1[6], o1[7]);
    w2.x = cvtpk(o2[0], o2[1]); w2.y = cvtpk(o2[2], o2[3]); w2.z = cvtpk(o2[4], o2[5]); w2.w = cvtpk(o2[6], o2[7]);
    *(LAS v4u*)(Ks + kswz(key, jq)) = w1; *(LAS v4u*)(Ks + kswz(key, 4 + jq)) = w2;
    if (cache_out) { *(GAS f32x4*)(cache_out + 8 * jq) = (f32x4){o1[0], o1[1], o1[2], o1[3]}; *(GAS f32x4*)(cache_out + 8 * jq + 4) = (f32x4){o1[4], o1[5], o1[6], o1[7]};
        *(GAS f32x4*)(cache_out + 32 + 8 * jq) = (f32x4){o2[0], o2[1], o2[2], o2[3]}; *(GAS f32x4*)(cache_out + 32 + 8 * jq + 4) = (f32x4){o2[4], o2[5], o2[6], o2[7]}; }
}
constexpr int SWA_KS = 0, SWA_VS = 32768, SWA_STG = 65536;

DI void swa_prompt_item(Frame& F, int item) {
    const int b = item >> 5, kvh = (item >> 4) & 1, i = item & 15;
    const bf16* PROJ = (const bf16*)(F.ws + WS_PROJ); bf16* MIX = (bf16*)(F.ws + WS_MIX); const float* ROPE = (const float*)(F.ws + WS_ROPE);
    LAS unsigned char* Ks = F.lds + RING_OFF + SWA_KS; LAS unsigned char* Vs = F.lds + RING_OFF + SWA_VS; LAS float* stg = (LAS float*)(F.lds + RING_OFF + SWA_STG + F.wave * 8192);
    int tid = F.tid; asm volatile("" : "+v"(tid));
    const int lane = tid & 63, r = lane & 31, h = lane >> 5;
    const float* knw = F.in[IN_KNW]; const float* qnw = F.in[IN_QNW];
    const int jq = tid & 3;
    f32x4 kw[4]; kw[0] = *(const GAS f32x4*)(knw + 8 * jq); kw[1] = *(const GAS f32x4*)(knw + 8 * jq + 4); kw[2] = *(const GAS f32x4*)(knw + 32 + 8 * jq); kw[3] = *(const GAS f32x4*)(knw + 32 + 8 * jq + 4);
    KRegs kr[2];
#pragma unroll
    for (int it = 0; it < 2; ++it) { const int key = (tid + 512 * it) >> 2; const int tok = 128 * (i - 1) + key; const bool ok = tok >= 0;
        kt_load(kr[it], ok ? PROJ + (size_t)(b * 2048 + tok) * NINP + C_SK + 64 * kvh : nullptr, ROPE + (size_t)(ok ? tok : 0) * 64, jq); }
    v4u vv[4];
#pragma unroll
    for (int it = 0; it < 4; ++it) { const int id = tid + 512 * it, key = id >> 3, c = id & 7; const int tok = 128 * (i - 1) + key;
        vv[it] = (v4u){0u, 0u, 0u, 0u}; if (tok >= 0) vv[it] = *(const GAS v4u*)(PROJ + (size_t)(b * 2048 + tok) * NINP + C_SV + 64 * kvh + 8 * c); }
#pragma unroll
    for (int it = 0; it < 2; ++it) { const int key = (tid + 512 * it) >> 2;
        float* co = (i == 15 && key >= 128) ? F.out + O_CKP + ((size_t)(b * 128 + (key - 128)) * 2 + kvh) * 64 : nullptr;
        kt_finish(Ks, key, jq, kr[it], kw, co); }
#pragma unroll
    for (int it = 0; it < 4; ++it) { const int id = tid + 512 * it, key = id >> 3, c = id & 7;
        *(LAS v4u*)(Vs + key * 128 + c * 16) = vv[it];
        if (i == 15 && key >= 128) { float* co = F.out + O_CVP + ((size_t)(b * 128 + (key - 128)) * 2 + kvh) * 64 + 8 * c; const bf16x8 v8 = __builtin_bit_cast(bf16x8, vv[it]);
            *(GAS f32x4*)co = (f32x4){bfs2f(v8[0]), bfs2f(v8[1]), bfs2f(v8[2]), bfs2f(v8[3])}; *(GAS f32x4*)(co + 4) = (f32x4){bfs2f(v8[4]), bfs2f(v8[5]), bfs2f(v8[6]), bfs2f(v8[7])}; } }
    QRegs q0;
    { const int tq = F.wave * 2, head = 4 * kvh + (tq >> 2), tokq = 128 * i + 32 * (tq & 3) + r; qf_load(q0, PROJ + (size_t)(b * 2048 + tokq) * NINP + C_SQ + 64 * head, ROPE + (size_t)tokq * 64, h); }
    __syncthreads();
    const int ktmin = (i == 0) ? 4 : 0;
#pragma unroll 1
    for (int qi = 0; qi < 2; ++qi) {
        const int tq = F.wave * 2 + qi, hq = tq >> 2, o = 32 * (tq & 3), head = 4 * kvh + hq;
        bf16x8 qf[4];
        {   f32x4 qw[8];
#pragma unroll
            for (int s = 0; s < 4; ++s) { qw[2 * s] = *(const GAS f32x4*)(qnw + 16 * s + 8 * h); qw[2 * s + 1] = *(const GAS f32x4*)(qnw + 16 * s + 8 * h + 4); }
            qf_make(qf, q0, qw); }
        if (qi == 0) { const int tq1 = tq + 1, head1 = 4 * kvh + (tq1 >> 2), tokq = 128 * i + 32 * (tq1 & 3) + r; qf_load(q0, PROJ + (size_t)(b * 2048 + tokq) * NINP + C_SQ + 64 * head1, ROPE + (size_t)tokq * 64, h); }
        const float sink2 = F.in[IN_SINK][head] * LOG2E;
        float ov[32];
        swa_tile(qf, Ks, Vs, stg, tq & 3, ktmin, r, sink2, ov, lane);
        swa_store_row(MIX + (size_t)(b * 2048 + 128 * i + o + (lane >> 1)) * D + 512 + 64 * head + 32 * (lane & 1), ov);
    }
    __syncthreads();
}
DI void swa_sample_item(Frame& F, int item) {
    const int b = item >> 1, kvh = item & 1;
    const bf16* PROJ = (const bf16*)(F.ws + WS_PROJ); bf16* MIX = (bf16*)(F.ws + WS_MIXS_V); const float* ROPE = (const float*)(F.ws + WS_ROPE);
    LAS unsigned char* Ks = F.lds + RING_OFF + SWA_KS; LAS unsigned char* Vs = F.lds + RING_OFF + SWA_VS; LAS float* stg = (LAS float*)(F.lds + RING_OFF + SWA_STG + F.wave * 8192);
    int tid = F.tid; asm volatile("" : "+v"(tid));
    const int lane = tid & 63, r = lane & 31, h = lane >> 5, jq = tid & 3;
    const float* knw = F.in[IN_KNW]; const float* qnw = F.in[IN_QNW];
    const float* CK = F.in[IN_CK]; const float* CV = F.in[IN_CV];
    f32x4 ck0, ck1, ck2, ck3;
    { const float* src = CK + ((size_t)(b * 128 + (tid >> 2)) * 2 + kvh) * 64; ck0 = __builtin_nontemporal_load((const GAS f32x4*)(src + 8 * jq)); ck1 = __builtin_nontemporal_load((const GAS f32x4*)(src + 8 * jq + 4)); ck2 = __builtin_nontemporal_load((const GAS f32x4*)(src + 32 + 8 * jq)); ck3 = __builtin_nontemporal_load((const GAS f32x4*)(src + 32 + 8 * jq + 4)); }
    f32x4 cv[2][2];
#pragma unroll
    for (int it = 0; it < 2; ++it) { const int id = tid + 512 * it, key = id >> 3, c = id & 7; const float* src = CV + ((size_t)(b * 128 + key) * 2 + kvh) * 64 + 8 * c; cv[it][0] = __builtin_nontemporal_load((const GAS f32x4*)src); cv[it][1] = __builtin_nontemporal_load((const GAS f32x4*)(src + 4)); }
    KRegs kn; f32x4 kw[4]; v4u vn = (v4u){0u, 0u, 0u, 0u};
    const int nkey = 128 + (tid >> 2); const int nt = nkey - 128; const bool nok = nt < 8;
    if (tid < 128) { kw[0] = *(const GAS f32x4*)(knw + 8 * jq); kw[1] = *(const GAS f32x4*)(knw + 8 * jq + 4); kw[2] = *(const GAS f32x4*)(knw + 32 + 8 * jq); kw[3] = *(const GAS f32x4*)(knw + 32 + 8 * jq + 4);
        kt_load(kn, nok ? PROJ + (size_t)(NPR + b * 8 + nt) * NINP + C_SK + 64 * kvh : nullptr, ROPE + (size_t)(2048 + (nok ? nt : 0)) * 64, jq); }
    const int vkey = 128 + (tid >> 3), vc = tid & 7;
    if (tid < 64) vn = *(const GAS v4u*)(PROJ + (size_t)(NPR + b * 8 + (vkey - 128)) * NINP + C_SV + 64 * kvh + 8 * vc);
    QRegs q0; f32x4 qw[8];
    const int hq = r >> 3, t = r & 7, head = 4 * kvh + hq;
    if (F.wave == 0) {
#pragma unroll
        for (int s = 0; s < 4; ++s) { qw[2 * s] = *(const GAS f32x4*)(qnw + 16 * s + 8 * h); qw[2 * s + 1] = *(const GAS f32x4*)(qnw + 16 * s + 8 * h + 4); }
        qf_load(q0, PROJ + (size_t)(NPR + b * 8 + t) * NINP + C_SQ + 64 * head, ROPE + (size_t)(2048 + t) * 64, h); }
    { const int key = tid >> 2;
        v4u w1, w2; w1.x = cvtpk(ck0.x, ck0.y); w1.y = cvtpk(ck0.z, ck0.w); w1.z = cvtpk(ck1.x, ck1.y); w1.w = cvtpk(ck1.z, ck1.w);
        w2.x = cvtpk(ck2.x, ck2.y); w2.y = cvtpk(ck2.z, ck2.w); w2.z = cvtpk(ck3.x, ck3.y); w2.w = cvtpk(ck3.z, ck3.w);
        *(LAS v4u*)(Ks + kswz(key, jq)) = w1; *(LAS v4u*)(Ks + kswz(key, 4 + jq)) = w2;
        if (key >= 8) { float* co = F.out + O_CKS + ((size_t)(b * 128 + (key - 8)) * 2 + kvh) * 64;
            __builtin_nontemporal_store(ck0, (GAS f32x4*)(co + 8 * jq)); __builtin_nontemporal_store(ck1, (GAS f32x4*)(co + 8 * jq + 4)); __builtin_nontemporal_store(ck2, (GAS f32x4*)(co + 32 + 8 * jq)); __builtin_nontemporal_store(ck3, (GAS f32x4*)(co + 32 + 8 * jq + 4)); } }
#pragma unroll
    for (int it = 0; it < 2; ++it) { const int id = tid + 512 * it, key = id >> 3, c = id & 7;
        v4u w; w.x = cvtpk(cv[it][0].x, cv[it][0].y); w.y = cvtpk(cv[it][0].z, cv[it][0].w); w.z = cvtpk(cv[it][1].x, cv[it][1].y); w.w = cvtpk(cv[it][1].z, cv[it][1].w);
        *(LAS v4u*)(Vs + key * 128 + c * 16) = w;
        if (key >= 8) { float* co = F.out + O_CVS + ((size_t)(b * 128 + (key - 8)) * 2 + kvh) * 64 + 8 * c; __builtin_nontemporal_store(cv[it][0], (GAS f32x4*)co); __builtin_nontemporal_store(cv[it][1], (GAS f32x4*)(co + 4)); } }
    if (tid < 128) kt_finish(Ks, nkey, jq, kn, kw, nok ? F.out + O_CKS + ((size_t)(b * 128 + 120 + nt) * 2 + kvh) * 64 : nullptr);
    if (tid < 256) { *(LAS v4u*)(Vs + vkey * 128 + vc * 16) = vn;
        if (tid < 64) { const bf16x8 v8 = __builtin_bit_cast(bf16x8, vn); float* co = F.out + O_CVS + ((size_t)(b * 128 + 120 + (vkey - 128)) * 2 + kvh) * 64 + 8 * vc;
            *(GAS f32x4*)co = (f32x4){bfs2f(v8[0]), bfs2f(v8[1]), bfs2f(v8[2]), bfs2f(v8[3])}; *(GAS f32x4*)(co + 4) = (f32x4){bfs2f(v8[4]), bfs2f(v8[5]), bfs2f(v8[6]), bfs2f(v8[7])}; } }
    __syncthreads();
    if (F.wave == 0) {
        bf16x8 qf[4]; qf_make(qf, q0, qw);
        const float sink2 = F.in[IN_SINK][head] * LOG2E;
        float ov[32];
        swa_tile(qf, Ks, Vs, stg, 0, 0, t, sink2, ov, lane);
        const int row = lane >> 1;
        swa_store_row(MIX + (size_t)(NPR + b * 8 + (row & 7)) * D + 512 + 64 * (4 * kvh + (row >> 3)) + 32 * (lane & 1), ov);
    }
    __syncthreads();
}

template <int NCH>
DI void gla_gates(Frame& F, LAS const float* GLR, LAS float* TOT, const float (&w)[16], float bg, float (&la)[8 * NCH], float& off, float& total) {
    constexpr int TPT = 8 * NCH, GPC = 8 / NCH;
    const int d = F.tid & 63, g = F.tid >> 6;
    float c = 0.f;
#pragma unroll
    for (int tt = 0; tt < TPT; ++tt) { float gl = bg;
#pragma unroll
        for (int r = 0; r < 16; ++r) gl += GLR[(TPT * g + tt) * 16 + r] * w[r];
        la[tt] = logsig_f(gl) * (1.f / 16.f); c += la[tt]; }
    TOT[g * 64 + d] = c;
    __syncthreads();
    const int g0 = (g / GPC) * GPC; float o_ = 0.f, t_ = 0.f;
#pragma unroll
    for (int gg = 0; gg < GPC; ++gg) { const float v = TOT[(g0 + gg) * 64 + d]; t_ += v; o_ += (g0 + gg < g) ? v : 0.f; }
    off = o_; total = t_;
}
constexpr int GA_GLR = 0, GA_TOT = 16384, GA_GD = 18432, GA_KH = 20480, GA_VS = 53248;
DI void gla_super_a(Frame& F, int sup) {
    const int bh = sup >> 3, j = sup & 7, b = bh >> 2, hh = bh & 3; const int tok0 = b * 2048 + 256 * j;
    const bf16* proj0 = (const bf16*)(F.ws + WS_PROJ) + (size_t)tok0 * NINP;
    LAS unsigned char* L = F.lds + RING_OFF; LAS float* GLR = (LAS float*)(L + GA_GLR); LAS float* TOT = (LAS float*)(L + GA_TOT); LAS float* GDs = (LAS float*)(L + GA_GD);
    LAS unsigned char* KH = L + GA_KH; LAS unsigned char* VS = L + GA_VS;
    int tid = F.tid; asm volatile("" : "+v"(tid));
    const int d = tid & 63, g = tid >> 6;
    {
        const int t = tid >> 1, half = tid & 1; const bf16x8 gv = *(const GAS bf16x8*)(proj0 + (size_t)t * NINP + C_GLR + 8 * half);
        v4u kv[4], vv[8];
#pragma unroll
        for (int it = 0; it < 4; ++it) { const int id = tid + 512 * it; kv[it] = *(const GAS v4u*)(proj0 + (size_t)(id >> 3) * NINP + C_GK + 64 * hh + 8 * (id & 7)); }
#pragma unroll
        for (int it = 0; it < 8; ++it) { const int id = tid + 512 * it; vv[it] = *(const GAS v4u*)(proj0 + (size_t)(id >> 4) * NINP + C_GV + 128 * hh + 8 * (id & 15)); }
#pragma unroll
        for (int jj = 0; jj < 8; ++jj) GLR[t * 16 + 8 * half + jj] = bfs2f(gv[jj]);
#pragma unroll
        for (int it = 0; it < 4; ++it) { const int id = tid + 512 * it; *(LAS v4u*)(KH + (id >> 3) * 128 + (id & 7) * 16) = kv[it]; }
#pragma unroll
        for (int it = 0; it < 8; ++it) { const int id = tid + 512 * it; *(LAS v4u*)(VS + (id >> 4) * 256 + (id & 15) * 16) = vv[it]; }
    }
    float w[16];
#pragma unroll
    for (int r = 0; r < 16; ++r) w[r] = F.in[IN_WGU][r * 256 + 64 * hh + d];
    const float bg = F.in[IN_BG][64 * hh + d];
    __syncthreads();
    float la[32], off, total; gla_gates<4>(F, GLR, TOT, w, bg, la, off, total);
    {   float run = off;
#pragma unroll
        for (int tt = 0; tt < 32; ++tt) { run += la[tt]; LAS unsigned short* kp = (LAS unsigned short*)(KH + (32 * g + tt) * 128 + d * 2);
            *kp = (unsigned short)f2bf(bf2f(*kp) * __expf(total - run)); }
        if ((g & 1) == 0) GDs[(g >> 1) * 64 + d] = __expf(total);
    }
    __syncthreads();
    const int lane = F.lane, h = lane >> 5, q4 = (lane & 15) >> 2, p4 = lane & 3, blk = (lane >> 4) & 1, r = lane & 31;
    const int mt = F.wave >> 2, nt = F.wave & 3;
    f32x16 R;
#pragma unroll
    for (int i = 0; i < 16; ++i) R[i] = 0.f;
#pragma unroll
    for (int c = 0; c < 4; ++c) {
        f32x16 U;
#pragma unroll
        for (int i = 0; i < 16; ++i) U[i] = 0.f;
#pragma unroll
        for (int ks = 0; ks < 4; ++ks) { const int rowb = 64 * c + 16 * ks + 8 * h + q4;
            LAS const unsigned char* pa = KH + rowb * 128 + (32 * mt + 16 * blk + 4 * p4) * 2; LAS const unsigned char* pb = VS + rowb * 256 + (32 * nt + 16 * blk + 4 * p4) * 2;
            U = __builtin_amdgcn_mfma_f32_32x32x16_bf16(cat8(trrd(pa), trrd(pa + 4 * 128)), cat8(trrd(pb), trrd(pb + 4 * 256)), U, 0, 0, 0); }
#pragma unroll
        for (int i = 0; i < 16; ++i) R[i] = GDs[c * 64 + 32 * mt + crow(i, h)] * R[i] + U[i];
    }
    float* T = (float*)(F.ws + WS_U) + (size_t)sup * 8192;
#pragma unroll
    for (int i = 0; i < 16; ++i) T[(32 * mt + crow(i, h)) * 128 + 32 * nt + r] = R[i];
    if (tid < 64) ((float*)(F.ws + WS_GD))[(size_t)sup * 64 + tid] = (GDs[tid] * GDs[64 + tid]) * (GDs[128 + tid] * GDs[192 + tid]);
    __syncthreads();
}
constexpr int GB_GLR = 0, GB_TOT = 8192, GB_GD = 10240, GB_GP = 10752, GB_QT = 16384, GB_KT = 32768, GB_KH = 49152, GB_VS = 65536, GB_SB = 98304, GB_OB = 16384;
DI float bufld_f32(__amdgpu_buffer_rsrc_t rs, unsigned voff, unsigned soff) { return __builtin_bit_cast(float, __builtin_amdgcn_raw_buffer_load_b32(rs, (int)voff, (int)soff, 0)); }
struct GlaBRegs { v4u gv, qv[2], kv[2], vv[4], grv[2][2]; };
DI void gla_b_load(GlaBRegs& R, const bf16* proj0, int hh, int tid) {
    R.gv = (v4u){0u, 0u, 0u, 0u}; if (tid < 256) R.gv = *(const GAS v4u*)(proj0 + (size_t)(tid >> 1) * NINP + C_GLR + 8 * (tid & 1));
#pragma unroll
    for (int it = 0; it < 2; ++it) { const int id = tid + 512 * it; R.qv[it] = *(const GAS v4u*)(proj0 + (size_t)(id >> 3) * NINP + C_GQ + 64 * hh + 8 * (id & 7));
        R.kv[it] = *(const GAS v4u*)(proj0 + (size_t)(id >> 3) * NINP + C_GK + 64 * hh + 8 * (id & 7)); }
#pragma unroll
    for (int it = 0; it < 4; ++it) { const int id = tid + 512 * it; R.vv[it] = *(const GAS v4u*)(proj0 + (size_t)(id >> 4) * NINP + C_GV + 128 * hh + 8 * (id & 15)); }
#pragma unroll
    for (int c = 0; c < 2; ++c) { const bf16* grp = proj0 + (size_t)(64 * c + (tid >> 3)) * NINP + C_GR + 128 * hh + 16 * (tid & 7); R.grv[c][0] = *(const GAS v4u*)grp; R.grv[c][1] = *(const GAS v4u*)(grp + 8); }
}
template <bool FIRST>
DI void gla_b_batch(Frame& F, int tid, const GlaBRegs& R, int tokb, int hh, int j, const float (&w)[16], float bg, f32x16& S, f32x16 (&Ta)[3], __amdgpu_buffer_rsrc_t Trs, unsigned tvoff, GlaBRegs& Rn, const bf16* projn) {
    LAS unsigned char* L = F.lds + RING_OFF; LAS float* GLR = (LAS float*)(L + GB_GLR); LAS float* TOT = (LAS float*)(L + GB_TOT); LAS float* GDs = (LAS float*)(L + GB_GD); LAS float* GP = (LAS float*)(L + GB_GP);
    LAS unsigned char* QT = L + GB_QT; LAS unsigned char* KT = L + GB_KT; LAS unsigned char* KH = L + GB_KH; LAS unsigned char* VS = L + GB_VS; LAS unsigned char* SB = L + GB_SB; LAS float* OB = (LAS float*)(L + GB_OB);
    const int d = tid & 63, g = tid >> 6;
    const int lane = tid & 63, r = lane & 31, h = lane >> 5, q4 = (lane & 15) >> 2, p4 = lane & 3, blk = (lane >> 4) & 1;
    const int mt = F.wave >> 2, nt = F.wave & 3;
    if (tid < 256) { const bf16x8 g8 = __builtin_bit_cast(bf16x8, R.gv);
#pragma unroll
        for (int jj = 0; jj < 8; ++jj) GLR[(tid >> 1) * 16 + 8 * (tid & 1) + jj] = bfs2f(g8[jj]); }
#pragma unroll
    for (int it = 0; it < 2; ++it) { const int id = tid + 512 * it; *(LAS v4u*)(QT + kswz(id >> 3, id & 7)) = R.qv[it]; *(LAS v4u*)(KT + kswz(id >> 3, id & 7)) = R.kv[it]; }
#pragma unroll
    for (int it = 0; it < 4; ++it) { const int id = tid + 512 * it; *(LAS v4u*)(VS + (id >> 4) * 256 + (id & 15) * 16) = R.vv[it]; }
    __syncthreads(); TSI(FIRST ? 31 : 41);
    f32x16 Tc[4];
    {
        float la[16], off, total; gla_gates<2>(F, GLR, TOT, w, bg, la, off, total);
        if (FIRST) {
#pragma unroll
            for (int jp = 0; jp < 3; ++jp)
#pragma unroll
                for (int i = 0; i < 16; ++i) S[i] = GP[jp * 64 + 32 * mt + crow(i, h)] * S[i] + Ta[jp][i];
#pragma unroll
            for (int jp = 0; jp < 4; ++jp)
#pragma unroll
                for (int i = 0; i < 16; ++i) Tc[jp][i] = (3 + jp < j) ? bufld_f32(Trs, tvoff, (unsigned)((3 + jp) * 32768 + ((i & 3) + 8 * (i >> 2)) * 512)) : 0.f;
        }
        float run = off; const float etot = __expf(total);
#pragma unroll
        for (int tt = 0; tt < 16; ++tt) { run += la[tt]; const int tl = 16 * g + tt; const unsigned sw = kswz(tl, d >> 3) + (d & 7) * 2;
            LAS unsigned short* qp = (LAS unsigned short*)(QT + sw); LAS unsigned short* kp = (LAS unsigned short*)(KT + sw);
            const float ep = __expf(run), en = __builtin_amdgcn_rcpf(ep), kk = bf2f(*kp) * en;
            *qp = (unsigned short)f2bf(bf2f(*qp) * 0.125f * ep); *kp = (unsigned short)f2bf(kk);
            *(LAS unsigned short*)(KH + tl * 128 + d * 2) = (unsigned short)f2bf(kk * etot); }
        if ((g & 3) == 0) GDs[(g >> 2) * 64 + d] = etot;
    }
    __syncthreads(); TSI(FIRST ? 32 : 42);
    if (FIRST) {
#pragma unroll
        for (int jp = 0; jp < 4; ++jp)
#pragma unroll
            for (int i = 0; i < 16; ++i) S[i] = GP[(3 + jp) * 64 + 32 * mt + crow(i, h)] * S[i] + Tc[jp][i];
    }
#pragma unroll
    for (int c = 0; c < 2; ++c) {
#pragma unroll
        for (int i = 0; i < 16; ++i) *(LAS unsigned short*)(SB + c * 16384 + (32 * mt + crow(i, h)) * 256 + (32 * nt + r) * 2) = (unsigned short)f2bf(S[i]);
        f32x16 U;
#pragma unroll
        for (int i = 0; i < 16; ++i) U[i] = 0.f;
#pragma unroll
        for (int ks = 0; ks < 4; ++ks) { const int rowb = 64 * c + 16 * ks + 8 * h + q4;
            LAS const unsigned char* pa = KH + rowb * 128 + (32 * mt + 16 * blk + 4 * p4) * 2; LAS const unsigned char* pb = VS + rowb * 256 + (32 * nt + 16 * blk + 4 * p4) * 2;
            U = __builtin_amdgcn_mfma_f32_32x32x16_bf16(cat8(trrd(pa), trrd(pa + 4 * 128)), cat8(trrd(pb), trrd(pb + 4 * 256)), U, 0, 0, 0); }
#pragma unroll
        for (int i = 0; i < 16; ++i) S[i] = GDs[c * 64 + 32 * mt + crow(i, h)] * S[i] + U[i];
    }
    __syncthreads(); TSI(FIRST ? 33 : 43);
    f32x16 o[2];
    const int colb = (32 * nt + 16 * blk + 4 * p4) * 2;
#pragma unroll
    for (int c = 0; c < 2; ++c) {
        bf16x8 qfr[4];
#pragma unroll
        for (int s = 0; s < 4; ++s) qfr[s] = *(LAS const bf16x8*)(QT + kswz(64 * c + 32 * mt + r, 2 * s + h));
#pragma unroll
        for (int i = 0; i < 16; ++i) o[c][i] = 0.f;
#pragma unroll
        for (int st = 0; st < 2; ++st) {
            if (st <= mt) {
                f32x16 pT;
#pragma unroll
                for (int i = 0; i < 16; ++i) pT[i] = 0.f;
#pragma unroll
                for (int s = 0; s < 4; ++s) { const bf16x8 a = *(LAS const bf16x8*)(KT + kswz(64 * c + 32 * st + r, 2 * s + h)); pT = __builtin_amdgcn_mfma_f32_32x32x16_bf16(a, qfr[s], pT, 0, 0, 0); }
                if (st == mt) {
#pragma unroll
                    for (int i = 0; i < 16; ++i) pT[i] = (crow(i, h) > r) ? 0.f : pT[i]; }
#pragma unroll
                for (int s2 = 0; s2 < 2; ++s2) {
                    v4u ww; ww.x = cvtpk(pT[8 * s2 + 0], pT[8 * s2 + 1]); ww.y = cvtpk(pT[8 * s2 + 2], pT[8 * s2 + 3]); ww.z = cvtpk(pT[8 * s2 + 4], pT[8 * s2 + 5]); ww.w = cvtpk(pT[8 * s2 + 6], pT[8 * s2 + 7]);
                    const int rowb = 64 * c + 32 * st + 16 * s2 + 4 * h + q4; LAS const unsigned char* pb = VS + rowb * 256 + colb;
                    o[c] = __builtin_amdgcn_mfma_f32_32x32x16_bf16(__builtin_bit_cast(bf16x8, ww), cat8(trrd(pb), trrd(pb + 8 * 256)), o[c], 0, 0, 0);
                }
            }
        }
#pragma unroll
        for (int s = 0; s < 4; ++s) { const int rowb = 16 * s + 8 * h + q4; LAS const unsigned char* pb = SB + c * 16384 + rowb * 256 + colb;
            o[c] = __builtin_amdgcn_mfma_f32_32x32x16_bf16(qfr[s], cat8(trrd(pb), trrd(pb + 4 * 256)), o[c], 0, 0, 0); }
    }
    if (FIRST) gla_b_load(Rn, projn, hh, tid);
    __syncthreads(); TSI(FIRST ? 34 : 44);
#pragma unroll
    for (int c = 0; c < 2; ++c)
#pragma unroll
        for (int i = 0; i < 16; ++i) OB[c * 8448 + (32 * mt + crow(i, h)) * 132 + 32 * nt + r] = o[c][i];
    __syncthreads();
    {
        const int t = tid >> 3, seg = tid & 7; const float* gnw = F.in[IN_GNW] + 16 * seg;
#pragma unroll
        for (int c = 0; c < 2; ++c) {
            float v[16]; float ss = 0.f;
#pragma unroll
            for (int i = 0; i < 4; ++i) { const f32x4 x = *(LAS const f32x4*)(OB + c * 8448 + t * 132 + 16 * seg + 4 * i); v[4 * i] = x.x; v[4 * i + 1] = x.y; v[4 * i + 2] = x.z; v[4 * i + 3] = x.w; ss += (x.x * x.x + x.y * x.y) + (x.z * x.z + x.w * x.w); }
            ss += __shfl_xor(ss, 1); ss += __shfl_xor(ss, 2); ss += __shfl_xor(ss, 4);
            const float rstd = __builtin_amdgcn_rsqf(ss * (1.f / 128.f) + EPS);
            const bf16x8 g0 = __builtin_bit_cast(bf16x8, R.grv[c][0]), g1 = __builtin_bit_cast(bf16x8, R.grv[c][1]);
            float ov[16];
#pragma unroll
            for (int i = 0; i < 8; ++i) { ov[i] = v[i] * rstd * gnw[i] * silu_f(bfs2f(g0[i])); ov[8 + i] = v[8 + i] * rstd * gnw[8 + i] * silu_f(bfs2f(g1[i])); }
            v4u w0, w1; w0.x = cvtpk(ov[0], ov[1]); w0.y = cvtpk(ov[2], ov[3]); w0.z = cvtpk(ov[4], ov[5]); w0.w = cvtpk(ov[6], ov[7]);
            w1.x = cvtpk(ov[8], ov[9]); w1.y = cvtpk(ov[10], ov[11]); w1.z = cvtpk(ov[12], ov[13]); w1.w = cvtpk(ov[14], ov[15]);
            { const __amdgpu_buffer_rsrc_t rsM = __builtin_amdgcn_make_buffer_rsrc((void*)(F.ws + WS_MIX), 0, MTOK * D * 2, 0x00020000);
              const unsigned bo = (unsigned)(((size_t)(tokb + 64 * c + t) * D + 128 * hh + 16 * seg) * 2); pg8::wt_store16(rsM, bo, w0); pg8::wt_store16(rsM, bo + 16, w1); }
        }
    }
    __syncthreads(); TSI(FIRST ? 35 : 45);
}
DI void gla_super_b(Frame& F, int sup) {
    const int bh = sup >> 3, j = sup & 7, b = bh >> 2, hh = bh & 3;
    LAS float* GP = (LAS float*)(F.lds + RING_OFF + GB_GP);
    int tid = F.tid; asm volatile("" : "+v"(tid));
    const int d = tid & 63;
    const int lane = tid & 63, r = lane & 31, h = lane >> 5;
    const int mt = F.wave >> 2, nt = F.wave & 3;
    const int tok0 = b * 2048 + 256 * j;
    const bf16* proj0 = (const bf16*)(F.ws + WS_PROJ) + (size_t)tok0 * NINP;
    const float* Tb = (const float*)(F.ws + WS_U) + (size_t)(bh * 8) * 8192; const float* Gb = (const float*)(F.ws + WS_GD) + (size_t)(bh * 8) * 64;
    TSI(29);
    GlaBRegs R0; gla_b_load(R0, proj0, hh, tid);
    const __amdgpu_buffer_rsrc_t Trs = __builtin_amdgcn_make_buffer_rsrc((void*)Tb, 0, 8 * 32768, 0x00020000);
    const unsigned tvoff = (unsigned)(((32 * mt + 4 * h) * 128 + 32 * nt + r) * 4);
    f32x16 Ta[3];
#pragma unroll
    for (int jp = 0; jp < 3; ++jp)
#pragma unroll
        for (int i = 0; i < 16; ++i) Ta[jp][i] = (jp < j) ? bufld_f32(Trs, tvoff, (unsigned)(jp * 32768 + ((i & 3) + 8 * (i >> 2)) * 512)) : 0.f;
    GP[tid] = (tid >> 6) < j ? Gb[tid] : 1.f;
    float w[16];
#pragma unroll
    for (int rr = 0; rr < 16; ++rr) w[rr] = F.in[IN_WGU][rr * 256 + 64 * hh + d];
    const float bg = F.in[IN_BG][64 * hh + d];
    f32x16 S;
#pragma unroll
    for (int i = 0; i < 16; ++i) S[i] = 0.f;
    GlaBRegs R1;
    gla_b_batch<true>(F, tid, R0, tok0, hh, j, w, bg, S, Ta, Trs, tvoff, R1, proj0 + (size_t)128 * NINP);
    gla_b_batch<false>(F, tid, R1, tok0 + 128, hh, j, w, bg, S, Ta, Trs, tvoff, R0, proj0);
    if (j == 7) {
        float* So = F.out + O_STP + (size_t)bh * 8192;
#pragma unroll
        for (int i = 0; i < 16; ++i) So[(32 * mt + crow(i, h)) * 128 + 32 * nt + r] = S[i];
    }
}
DI void gla_sample_pair(Frame& F, int item0) {
    LAS float* L = (LAS float*)(F.lds + RING_OFF);
    int tid = F.tid; asm volatile("" : "+v"(tid));
    constexpr int BLK = 11008, O_GLR = 0, O_QS = 128, O_KS = 640, O_KH = 1152, O_GD = 1664, O_AT = 1728, O_VS = 1792, O_S0 = 2816;
    const bf16* PROJ = (const bf16*)(F.ws + WS_PROJ);
    f32x4 s0v[2][4];
#pragma unroll
    for (int u = 0; u < 2; ++u) { const int item = item0 + 256 * u, b = item >> 2, hh = item & 3; const float* S0 = F.in[IN_STATE] + (size_t)(b * 4 + hh) * 8192;
#pragma unroll
        for (int it = 0; it < 4; ++it) s0v[u][it] = __builtin_nontemporal_load((const GAS f32x4*)(S0 + 4 * (tid + 512 * it))); }
    {   const int u = tid >> 8, t2 = tid & 255; const int item = item0 + 256 * u, b = item >> 2, hh = item & 3; const bf16* proj0 = PROJ + (size_t)(NPR + 8 * b) * NINP; LAS float* Lu = L + u * BLK;
        if (t2 < 16) { const int t = t2 >> 1, half = t2 & 1; const bf16x8 v = *(const GAS bf16x8*)(proj0 + (size_t)t * NINP + C_GLR + 8 * half);
#pragma unroll
            for (int j = 0; j < 8; ++j) Lu[O_GLR + t * 16 + 8 * half + j] = bfs2f(v[j]); }
        if (t2 >= 128) { const int t = (t2 - 128) >> 4, c = t2 & 15; const bf16x8 v = *(const GAS bf16x8*)(proj0 + (size_t)t * NINP + C_GV + 128 * hh + 8 * c);
#pragma unroll
            for (int j = 0; j < 8; ++j) Lu[O_VS + t * 128 + 8 * c + j] = bfs2f(v[j]); } }
#pragma unroll
    for (int u = 0; u < 2; ++u)
#pragma unroll
        for (int it = 0; it < 4; ++it) *(LAS f32x4*)(L + u * BLK + O_S0 + 4 * (tid + 512 * it)) = s0v[u][it];
    __syncthreads();
    if (tid < 128) { const int u = tid >> 6, d = tid & 63; const int item = item0 + 256 * u, b = item >> 2, hh = item & 3; const bf16* proj0 = PROJ + (size_t)(NPR + 8 * b) * NINP; LAS float* Lu = L + u * BLK;
        float w[16];
#pragma unroll
        for (int r = 0; r < 16; ++r) w[r] = F.in[IN_WGU][r * 256 + 64 * hh + d];
        const float bg = F.in[IN_BG][64 * hh + d]; float bcl[8]; float c = 0.f;
        float qv[8], kv[8];
#pragma unroll
        for (int t = 0; t < 8; ++t) { qv[t] = bf2f(proj0[(size_t)t * NINP + C_GQ + 64 * hh + d]); kv[t] = bf2f(proj0[(size_t)t * NINP + C_GK + 64 * hh + d]); }
#pragma unroll
        for (int t = 0; t < 8; ++t) { float gl = bg;
#pragma unroll
            for (int r = 0; r < 16; ++r) gl += Lu[O_GLR + t * 16 + r] * w[r];
            c += logsig_f(gl) * (1.f / 16.f); bcl[t] = c; }
#pragma unroll
        for (int t = 0; t < 8; ++t) { const float ep = __expf(bcl[t]);
            Lu[O_QS + t * 64 + d] = qv[t] * 0.125f * ep; Lu[O_KS + t * 64 + d] = kv[t] * __expf(-bcl[t]); Lu[O_KH + t * 64 + d] = kv[t] * __expf(c - bcl[t]); }
        Lu[O_GD + d] = __expf(c);
    }
    __syncthreads();
    if (tid < 128) { const int u = tid >> 6, t = (tid >> 3) & 7, s = tid & 7; LAS float* Lu = L + u * BLK; float a = 0.f;
        for (int d = 0; d < 64; ++d) a += Lu[O_QS + t * 64 + d] * Lu[O_KS + s * 64 + d];
        Lu[O_AT + t * 8 + s] = (s <= t) ? a : 0.f; }
    __syncthreads();
    {   const int t = F.wave, lane = tid & 63; const float* gnw = F.in[IN_GNW];
#pragma unroll
        for (int u = 0; u < 2; ++u) { const int item = item0 + 256 * u, b = item >> 2, hh = item & 3; const bf16* proj0 = PROJ + (size_t)(NPR + 8 * b) * NINP; LAS float* Lu = L + u * BLK;
            const float gr0 = bf2f(proj0[(size_t)t * NINP + C_GR + 128 * hh + lane]), gr1 = bf2f(proj0[(size_t)t * NINP + C_GR + 128 * hh + 64 + lane]);
            float o0 = 0.f, o1 = 0.f;
            for (int d = 0; d < 64; ++d) { const float q = Lu[O_QS + t * 64 + d]; o0 += q * Lu[O_S0 + d * 128 + lane]; o1 += q * Lu[O_S0 + d * 128 + 64 + lane]; }
#pragma unroll
            for (int s = 0; s < 8; ++s) { const float a = Lu[O_AT + t * 8 + s]; o0 += a * Lu[O_VS + s * 128 + lane]; o1 += a * Lu[O_VS + s * 128 + 64 + lane]; }
            const float rstd = __builtin_amdgcn_rsqf(wave_sum(o0 * o0 + o1 * o1) * (1.f / 128.f) + EPS);
            bf16* op = (bf16*)(F.ws + WS_MIXS_V) + (size_t)(NPR + 8 * b + t) * D + 128 * hh;
            op[lane] = (bf16)f2bf(o0 * rstd * gnw[lane] * silu_f(gr0)); op[64 + lane] = (bf16)f2bf(o1 * rstd * gnw[64 + lane] * silu_f(gr1)); }
    }
#pragma unroll
    for (int u = 0; u < 2; ++u) { const int item = item0 + 256 * u, b = item >> 2, hh = item & 3; LAS float* Lu = L + u * BLK; float* So = F.out + O_STS + (size_t)(b * 4 + hh) * 8192;
#pragma unroll
        for (int it = 0; it < 4; ++it) { const int id = tid + 512 * it, d = id >> 5, e4 = id & 31; const f32x4 s0 = *(LAS const f32x4*)(Lu + O_S0 + d * 128 + 4 * e4); f32x4 a = s0 * Lu[O_GD + d];
#pragma unroll
            for (int s = 0; s < 8; ++s) a += *(LAS const f32x4*)(Lu + O_VS + s * 128 + 4 * e4) * Lu[O_KH + s * 64 + d];
            __builtin_nontemporal_store(a, (GAS f32x4*)(So + d * 128 + 4 * e4)); } }
    __syncthreads();
}
DI void slab_reduce_rows(Frame& F, int tile, int r0) {
    const float* MOD = (const float*)(F.ws + WS_MOD); const bf16* HB = (const bf16*)(F.ws + WS_HB);
    const int pm4 = tile >> 2, pn = tile & 3;
#pragma unroll 1
    for (int q0 = 0; q0 < 8; q0 += 4) {
        f32x4 a[4][4]; u32x2 hw[4]; f32x4 g2[4];
#pragma unroll
        for (int q = 0; q < 4; ++q) { const int rr = r0 + 8 * F.wave + q0 + q; const int m = NPR + 256 * pm4 + rr; const int mr = modrow(m);
            const float* SL = (const float*)(F.ws + WS_SLAB_FF2) + (size_t)(tile * 4) * 65536 + (size_t)rr * 256 + 4 * F.lane;
#pragma unroll
            for (int ks = 0; ks < 4; ++ks) a[q][ks] = __builtin_nontemporal_load((const GAS f32x4*)(SL + (size_t)ks * 65536));
            hw[q] = *((const GAS u32x2*)(HB + (size_t)m * D + 256 * pn) + F.lane);
            g2[q] = *((const GAS f32x4*)(MOD + (size_t)mr * NADA + 5120 + 256 * pn) + F.lane); }
#pragma unroll
        for (int q = 0; q < 4; ++q) { const int rr = r0 + 8 * F.wave + q0 + q; const int m = NPR + 256 * pm4 + rr;
            const f32x4 s = (a[q][0] + a[q][1]) + (a[q][2] + a[q][3]);
            const f32x4 hv = (f32x4){__uint_as_float(hw[q].x << 16), __uint_as_float(hw[q].x & 0xffff0000u), __uint_as_float(hw[q].y << 16), __uint_as_float(hw[q].y & 0xffff0000u)};
            __builtin_nontemporal_store(hv + g2[q] * s, (GAS f32x4*)(F.out + O_Y + (size_t)m * D + 256 * pn) + F.lane); }
    }
}

DI bool refresh(Frame& F) { int t = threadIdx.x; asm volatile("" : "+v"(t)); F.tid = t; F.lane = t & 63; return true; }

struct Args { const float* in[21]; float* out; unsigned char* ws; float invf[32]; int ph_lo, ph_hi, li, pad; };
constexpr int N_PHASES = 5;
__global__ void __launch_bounds__(NWAVES * 64, 2) fwd_kernel(Args args) {
    extern __shared__ __attribute__((aligned(16))) unsigned char lds[];
    Frame F;
    F.lds = (LAS unsigned char*)lds;
    F.MISC = (volatile LAS unsigned*)(F.lds + MISC_OFF);
    F.tid = threadIdx.x; F.lane = F.tid & 63; F.wave = __builtin_amdgcn_readfirstlane(F.tid >> 6);
    F.G = gridDim.x; { const int bx = blockIdx.x; F.vcu = (F.G % 8 == 0) ? (bx % 8) * (F.G / 8) + bx / 8 : bx; }
    F.in = args.in; F.out = args.out; F.ws = args.ws; F.invf = args.invf;
    F.ctl = (gu32*)(args.ws + WS_CTL);
    for (int u = F.tid; u < (LDS_BYTES - LDSCTL_OFF) / 4; u += NWAVES * 64) ((LAS unsigned*)(F.lds + LDSCTL_OFF))[u] = 0u;
    __syncthreads();
    if (F.G != 256) return;
    const int lo = args.ph_lo, hi = args.ph_hi;
    const bool multi = (hi - lo) > 1;
    XcdBarrier bar; bar.bar = (unsigned*)(F.ctl + CW_BAR) + args.li * XCD_BAR_WORDS; bar.x = 0; bar.st = nullptr;
    if (multi) bar = xcd_barrier_post((unsigned*)(F.ctl + CW_BAR) + args.li * XCD_BAR_WORDS, F.MISC + 8);
#define IN(k) (lo <= (k) && (k) < hi && refresh(F))
#define SEAM(k) do { if (IN(k) && IN((k) + 1)) xcd_barrier(bar); } while (0)
#define XN ((bf16*)(args.ws + WS_XN))
#define MOD ((float*)(args.ws + WS_MOD))

    enum { PH_FRONT = 0, PH_INPROJ, PH_MIXA, PH_MIXB, PH_FF1, PH_FF2 = 100   };
    TS(0);
    if (IN(PH_FRONT)) {
        unsigned* cnta = (unsigned*)(F.ctl + CW_CNTA);
        const int gw0 = (int)blockIdx.x * NWAVES + F.wave, ngw = F.G * NWAVES;
        if ((int)blockIdx.x < NADAWG) front_ada_slice(F, (int)blockIdx.x);
        conv_set(F, 1, gw0, ngw, 0, 1);
        asm volatile("s_waitcnt vmcnt(0)" ::: "memory"); __syncthreads();
        if (F.tid == 0) __hip_atomic_fetch_add(cnta, 1u, __ATOMIC_RELAXED, __HIP_MEMORY_SCOPE_AGENT);
        if ((int)blockIdx.x < NADAWG) { TSI(12);
            pg8::cnt_wait(cnta, (unsigned)F.G);
            pg8::Gemm g{(const pg8::bf16_t*)(args.ws + WS_SC), (const pg8::bf16_t*)(args.ws + WS_WADA), 256, NADA, D, D, D, nullptr}; pg8::AdaSplit S; S.c = (int)blockIdx.x;
            pg8::EpiSlab E{(float*)(args.ws + WS_SLAB_ADA)};
            pg8::gemm_phase<pg8::EpiSlab, pg8::AdaSplit, true, true>(F.lds + RING_OFF, g, S, E); TSI(13); refresh(F);
            asm volatile("s_waitcnt vmcnt(0)" ::: "memory"); __syncthreads();
            if (F.tid == 0 && (int)blockIdx.x < 32) __hip_atomic_fetch_add((unsigned*)(F.ctl + CW_CNTB), 1u, __ATOMIC_RELAXED, __HIP_MEMORY_SCOPE_AGENT); }
        else { const int wk = ((int)blockIdx.x - NADAWG) * NWAVES + F.wave, nwk = (F.G - NADAWG) * NWAVES; TSI(12); front_rope(F, wk, nwk); TSI(13); }
        if ((int)blockIdx.x >= NADAWG) {
            const int wk2 = gw0 - NADAWG * NWAVES;
            if (wk2 < 256) { LAS float* scr = (LAS float*)(F.lds + RING_OFF + F.wave * 16384);
                const ConvJob jIn{F.in[IN_WIN], D, NIN, 0, NINP / 32, (bf16*)(F.ws + WS_WIN), D}; ConvJob J[2] = {jIn, jIn}; int item[2] = {4096 + wk2 - (D / 64) * (NADA / 32), 0}; bool on[2] = {true, false};
                p0_transpose_batch<2, false>(J, item, on, scr, F.lane); } }
        __syncthreads(); refresh(F);
        TS(11);
        norm1_merged(F, (const unsigned*)(F.ctl + CW_CNTB));
    } SEAM(PH_FRONT); TS(1); TS(2);
    if (IN(PH_INPROJ)) { { pg8::Gemm g{XN, (const pg8::bf16_t*)(args.ws + WS_WIN), MTOK, NINP, D, D, D, GTS(PH_INPROJ)}; pg8::StaticOrder S; S.init(MTOK, NINP, F.G, (int)blockIdx.x, D);
        pg8::EpiBf16<0> E{(pg8::bf16_t*)(args.ws + WS_PROJ), NINP};
        pg8::gemm_phase<pg8::EpiBf16<0>, pg8::StaticOrder, true, true>(F.lds + RING_OFF, g, S, E); }
        const int nfree0 = (MTOK / 256) * (NINP / 256) - 2 * F.G;
        const int cfree = (int)blockIdx.x - nfree0;
        if (cfree >= 0 && cfree < 16) { refresh(F); ada_combine(F, 8 + cfree); }
        else if (cfree >= 16) conv_set(F, 2, (cfree - 16) * NWAVES + F.wave, (F.G - nfree0 - 16) * NWAVES);
        TS(12);
    } SEAM(PH_INPROJ); TS(3);
    if (IN(PH_MIXA)) {
        swa_prompt_item(F, F.vcu);
        TSI(20);
        swa_sample_item(F, F.vcu);
        TSI(21);
        gla_super_a(F, F.vcu);
        TSI(22);
        gla_sample_pair(F, F.vcu);
        TSI(23);
    } SEAM(PH_MIXA); TS(4);
    if (IN(PH_MIXB)) {
        unsigned* cntm = (unsigned*)(F.ctl + CW_CNTM);
        gla_super_b(F, F.vcu); TSI(30);
        asm volatile("s_waitcnt vmcnt(0)" ::: "memory"); __syncthreads();
        { const int sup = F.vcu; const int pm = (sup >> 5) * 8 + (sup & 7);
          if (F.tid == 0) __hip_atomic_fetch_add(cntm + 32 * pm, 1u, __ATOMIC_RELAXED, __HIP_MEMORY_SCOPE_AGENT); }
        refresh(F);
        TS(5);
        { pg8::Gemm g{(const pg8::bf16_t*)(args.ws + WS_MIX), (const pg8::bf16_t*)(args.ws + WS_WOUT), NPR, D, D, D, D, GTS(PH_MIXB)}; pg8::OutPOrder S; S.init(F.vcu, D); S.cnt = cntm;
          pg8::EpiOutNorm E{args.in[IN_XP], (pg8::bf16_t*)(args.ws + WS_HB), (pg8::bf16_t*)(args.ws + WS_XN), MOD, NADA, args.in[IN_N2], (float*)(args.ws + WS_XS), (unsigned*)(F.ctl + CW_CNTX), (LAS float*)(F.lds + LDSCTL_OFF + 4096), EPS};
          pg8::gemm_phase<pg8::EpiOutNorm, pg8::OutPOrder, true, true>(F.lds + RING_OFF, g, S, E); }
    } SEAM(PH_MIXB); TS(6);
    if (IN(PH_FF1)) {
        unsigned* cntp = (unsigned*)(F.ctl + CW_CNTP); unsigned* cnts = (unsigned*)(F.ctl + CW_CNTS);
        unsigned* cntq = (unsigned*)(F.ctl + CW_CNTQ); unsigned* cntr = cntq + 4 * 32;
        { const int q = (int)blockIdx.x - 192; if (q >= 0) {
            pg8::Gemm g{(const pg8::bf16_t*)(args.ws + WS_MIXS_V), (const pg8::bf16_t*)(args.ws + WS_WOUT), MTOK, D, D, D, D, nullptr}; pg8::SubOnly<4> S; S.init(D, q, D); S.cnt = cntq;
            pg8::EpiGate<0> E{args.in[IN_XP], (pg8::bf16_t*)(args.ws + WS_HB), nullptr, MOD + 2048, NADA, (float*)(args.ws + WS_SLAB_OUT)};
            pg8::gemm_phase<pg8::EpiGate<0>, pg8::SubOnly<4>, true, true>(F.lds + RING_OFF, g, S, E); refresh(F);
            TS(40);
            norm2_sample(F, q, cntq, cntr); refresh(F);
            TS(43);
        } }
        { pg8::Gemm g{XN, (const pg8::bf16_t*)(args.ws + WS_W1), MTOK, FF, D, D, D, GTS(PH_FF1)}; pg8::Ff1Order S; S.init(FF, F.G, (int)blockIdx.x, D); S.cnt = cntp; S.cntr = cntr;
          pg8::EpiBf16WT<2> E{(pg8::bf16_t*)(args.ws + WS_HID), FFP, (size_t)MTOK * FFP * 2};
          pg8::gemm_phase<pg8::EpiBf16WT<2>, pg8::Ff1Order, true, true>(F.lds + RING_OFF, g, S, E); }
        TSI(8);
        { pg8::Gemm g{(const pg8::bf16_t*)(args.ws + WS_HID), (const pg8::bf16_t*)(args.ws + WS_W2), MTOK, D, FF, FFP, FFP, GTS(PH_FF2)}; pg8::Ff2Order<4> S; S.init(D, F.G, (int)blockIdx.x, FF, 64); S.cntp = cntp; S.cnts = cnts;
          pg8::EpiGate<1> E{nullptr, (pg8::bf16_t*)(args.ws + WS_HB), args.out + O_Y, MOD + 5120, NADA, (float*)(args.ws + WS_SLAB_FF2)};
          pg8::gemm_phase<pg8::EpiGate<1>, pg8::Ff2Order<4>, true, true>(F.lds + RING_OFF, g, S, E); }
        TSI(9);
        { const int s = (int)blockIdx.x - 64; if (s >= 0 && s < 64) {
            pg8::cnt_wait(cnts + 64 * (s >> 2), 32u);
            slab_reduce_rows(F, s >> 2, 64 * (s & 3));
        } }
    }
#if INSTR
    TS(10);
    if ((int)blockIdx.x == INSTR_BLOCK) {
        LAS float* sh = (LAS float*)(F.lds + RING_OFF);
        if (F.tid == 0) { asm volatile("s_waitcnt vmcnt(0)" ::: "memory"); const volatile unsigned long long* ts = (const volatile unsigned long long*)(F.ws + WS_CTL + 8192);
            const float d1 = (float)(long long)(ts[INSTR_B1] - ts[INSTR_A1]) * 0.01f, d2 = (float)(long long)(ts[INSTR_B2] - ts[INSTR_A2]) * 0.01f;
            F.out[O_CVP] += d1 * INSTR_S1; sh[0] = 0.005f + d2 * INSTR_S2; }
        __syncthreads();
        const float dl = sh[0];
        for (int i = F.tid; i < 131072; i += 512) F.out[O_CKP + i] += dl;
    }
#endif
#undef IN
#undef SEAM
#undef XN
#undef MOD
}

#ifndef LAUNCH_PLAN
#define LAUNCH_PLAN {0, 5}
#endif
extern "C" void kernel_launch(void* const* d_in, const int* in_sizes, int n_in, void* d_out, int out_size, void* d_ws, size_t ws_size, hipStream_t stream) {
    static int grid = 0;
    if (grid == 0) {
        if (n_in != 21 || out_size != (int)O_END || ws_size < WS_MIXS + 2 * MiB) { fprintf(stderr, "kernel_launch: unexpected shapes (n_in %d, out %d, ws %zu)\n", n_in, out_size, ws_size); grid = -1; return; }
        int dev = 0, cus = 0, per_cu = 0;
        if (hipGetDevice(&dev) != hipSuccess || hipDeviceGetAttribute(&cus, hipDeviceAttributeMultiprocessorCount, dev) != hipSuccess) { grid = -1; return; }
        if (hipFuncSetAttribute((const void*)fwd_kernel, hipFuncAttributeMaxDynamicSharedMemorySize, LDS_BYTES) != hipSuccess) { fprintf(stderr, "kernel_launch: hipFuncSetAttribute failed\n"); grid = -1; return; }
        if (hipOccupancyMaxActiveBlocksPerMultiprocessor(&per_cu, (const void*)fwd_kernel, NWAVES * 64, LDS_BYTES) != hipSuccess || per_cu < 1) { fprintf(stderr, "kernel_launch: occupancy query says %d\n", per_cu); }
        (void)hipGetLastError();
        grid = cus;
        if (grid != 256) { fprintf(stderr, "kernel_launch: built for a 256-CU device, found %d CUs; nothing launched\n", cus); grid = -1; return; }
    }
    if (grid < 0) return;
    (void)hipMemsetAsync((char*)d_ws + WS_CTL, 0, CTL_ZERO_BYTES, stream);
    Args a{};
    for (int i = 0; i < 21; ++i) a.in[i] = (const float*)d_in[i];
    a.out = (float*)d_out; a.ws = (unsigned char*)d_ws;
    for (int j = 0; j < 32; ++j) a.invf[j] = (float)pow(10000.0, -(double)j / 32.0);
    const int plan[] = LAUNCH_PLAN;
    for (unsigned li = 0; li + 1 < sizeof(plan) / sizeof(plan[0]); li += 2) { a.ph_lo = plan[li]; a.ph_hi = plan[li + 1]; a.li = (int)(li / 2);
        hipLaunchKernelGGL(fwd_kernel, dim3(grid), dim3(NWAVES * 64), LDS_BYTES, stream, a); }
}
```

```cpp
#include <hip/hip_runtime.h>
#include <hip/hip_bf16.h>
#include <cstdio>
#include <cstdint>
#include <cmath>
namespace pg8 {
#define PG8_LAS __attribute__((address_space(3)))
typedef unsigned short bf16_t;
typedef short bf16x8 __attribute__((ext_vector_type(8)));
typedef float f32x4 __attribute__((ext_vector_type(4)));
typedef unsigned u32x4 __attribute__((ext_vector_type(4)));
constexpr int BM = 256, BK = 64, HALF = 128, HTB = HALF * BK * 2  , STAGE_BYTES = 8 * HTB, NXCD = 8, WGM = 8;

__host__ __device__ __forceinline__ int lds_byte(int r, int c) { const int st = (r >> 4) * 2 + (c >> 5), rr = r & 15, cc = c & 31, ob = rr * 64 + cc * 2; return st * 1024 + (ob ^ (((ob >> 9) & 1) << 5)); }
__host__ __device__ __forceinline__ void stage_rc(int b, int& R, int& C) { const int st = b / 1024, sb = b % 1024, swz = sb ^ (((sb >> 9) & 1) << 5); R = (st >> 1) * 16 + swz / 64; C = (st & 1) * 32 + (swz % 64) / 2; }
__host__ __device__ __forceinline__ int perm32(int rho) { const int n = rho >> 4, i = rho & 15; return 8 * (i >> 2) + 4 * n + (i & 3); }

struct Unit { int pm, pn, kt0, nkt, slab; };
struct Gemm { const bf16_t* A; const bf16_t* Bt; int M, N, K, lda, ldb; unsigned long long* ts; };
#define PG8_TS(k) do { if (g.ts && threadIdx.x == 0) g.ts[k] = __builtin_amdgcn_s_memrealtime(); } while (0)

template <class S> struct SchedDefer { static constexpr bool value = false; };
struct StaticOrder {
    int nM, nN, nwg, G, c, nkt;
    __host__ __device__ void init(int M, int N, int G_, int c_, int K_) { nM = M / BM; nN = N / BM; nwg = nM * nN; G = G_; c = c_; nkt = K_ / BK; }
    __host__ __device__ __forceinline__ bool next(int i, Unit& u) const {
        const long L = (long)i * G + c; if (L >= nwg) return false;
        return at((int)L, u); }
    __host__ __device__ __forceinline__ bool at(int L, Unit& u) const {
        u.kt0 = 0; u.nkt = nkt; u.slab = -1;
        int wgid = L; { const int q = nwg / NXCD, r = nwg % NXCD, xcd = wgid % NXCD, off = wgid / NXCD; wgid = (xcd < r ? xcd * (q + 1) : r * (q + 1) + (xcd - r) * q) + off; }
        const int nig = WGM * nN, gid = wgid / nig, fm = gid * WGM, gsz = (nM - fm) < WGM ? (nM - fm) : WGM;
        u.pm = fm + ((wgid % nig) % gsz); u.pn = (wgid % nig) / gsz; return true;
    }
    __device__ __forceinline__ void a_ready(const Unit&) const {}
    __device__ __forceinline__ void done(const Unit&) const {}
};

typedef float f32x2_t __attribute__((ext_vector_type(2))); typedef __bf16 bf16x2_t __attribute__((ext_vector_type(2)));
__device__ __forceinline__ unsigned cvt_pk_bf16(float lo, float hi) { f32x2_t v = {lo, hi}; bf16x2_t b = __builtin_convertvector(v, bf16x2_t); return __builtin_bit_cast(unsigned, b); }

#define PG8_WT_AUX 16
__device__ __forceinline__ void wt_store16(__amdgpu_buffer_rsrc_t rs, unsigned byte_off, u32x4 v) { __builtin_amdgcn_raw_buffer_store_b128(v, rs, (int)byte_off, 0, PG8_WT_AUX); }
__device__ __forceinline__ void cnt_arrive(unsigned* cnt) {
    asm volatile("s_waitcnt vmcnt(0)" ::: "memory");
    if ((threadIdx.x & 63) == 0) __hip_atomic_fetch_add(cnt, 1u, __ATOMIC_RELAXED, __HIP_MEMORY_SCOPE_AGENT);
}
__device__ __forceinline__ void cnt_wait(const unsigned* cnt, unsigned need) {
    if (threadIdx.x < 64) {
        unsigned spins = 0;
        while ((unsigned)__builtin_amdgcn_readfirstlane(__hip_atomic_load(cnt, __ATOMIC_RELAXED, __HIP_MEMORY_SCOPE_AGENT)) < need) { __builtin_amdgcn_s_sleep(4); if (++spins > (1u << 22)) break; }
        __builtin_amdgcn_fence(__ATOMIC_ACQUIRE, "agent");
        asm volatile("s_waitcnt vmcnt(0)" ::: "memory");
    }
    asm volatile("" ::: "memory"); __builtin_amdgcn_s_barrier(); asm volatile("" ::: "memory");
}
__device__ __forceinline__ void cnt_wait_nofence(const unsigned* cnt, unsigned need) {
    if (threadIdx.x < 64) {
        unsigned spins = 0;
        while ((unsigned)__builtin_amdgcn_readfirstlane(__hip_atomic_load(cnt, __ATOMIC_RELAXED, __HIP_MEMORY_SCOPE_AGENT)) < need) { __builtin_amdgcn_s_sleep(2); if (++spins > (1u << 22)) break; }
    }
    asm volatile("" ::: "memory"); __builtin_amdgcn_s_barrier(); asm volatile("" ::: "memory");
}
struct EpiF32 {
    static constexpr bool PERM = false, AFTER_DRAIN = false;
    float* C; int ldc; const float* bias;
    __device__ __forceinline__ void operator()(const f32x4 (&acc)[2][2][4][2], const Unit& u, int wr, int wc, int fr, int fq) const {
        const int row0 = u.pm * BM + wr * 64 + fr, col0 = u.pn * BM + wc * 32 + 4 * fq;
        f32x4 bv[2][2];
#pragma unroll
        for (int bj = 0; bj < 2; ++bj)
#pragma unroll
            for (int n = 0; n < 2; ++n) bv[bj][n] = bias ? *(const f32x4*)(bias + col0 + bj * HALF + n * 16) : (f32x4){0.f, 0.f, 0.f, 0.f};
#pragma unroll
        for (int ai = 0; ai < 2; ++ai)
#pragma unroll
            for (int m = 0; m < 4; ++m) { float* rowp = C + (size_t)(row0 + ai * HALF + m * 16) * ldc + col0;
#pragma unroll
                for (int bj = 0; bj < 2; ++bj)
#pragma unroll
                    for (int n = 0; n < 2; ++n) *(f32x4*)(rowp + bj * HALF + n * 16) = acc[ai][bj][m][n] + bv[bj][n]; }
    }
};
template <int ACT  > struct EpiBf16 {
    static constexpr bool PERM = true, AFTER_DRAIN = false;
    bf16_t* O; int ldc;
    __device__ __forceinline__ void operator()(const f32x4 (&acc)[2][2][4][2], const Unit& u, int wr, int wc, int fr, int fq) const {
        const int row0 = u.pm * BM + wr * 64 + fr; const int colt = u.pn * BM;
        const int col0 = colt + wc * 32 + 8 * fq;
#pragma unroll
        for (int ai = 0; ai < 2; ++ai)
#pragma unroll
            for (int m = 0; m < 4; ++m) { bf16_t* rowp = O + (size_t)(row0 + ai * HALF + m * 16) * ldc + col0;
#pragma unroll
                for (int bj = 0; bj < 2; ++bj) { f32x4 v0 = acc[ai][bj][m][0], v1 = acc[ai][bj][m][1];
                    if (ACT == 2) {
#pragma unroll
                        for (int j = 0; j < 4; ++j) { const float a = __builtin_fmaxf(v0[j], 0.f), b = __builtin_fmaxf(v1[j], 0.f); v0[j] = a * a; v1[j] = b * b; } }
                    u32x4 w; w.x = cvt_pk_bf16(v0[0], v0[1]); w.y = cvt_pk_bf16(v0[2], v0[3]); w.z = cvt_pk_bf16(v1[0], v1[1]); w.w = cvt_pk_bf16(v1[2], v1[3]);
                    *(u32x4*)(rowp + bj * HALF) = w; } }
    }
};
template <int MODE> struct EpiGate {
    static constexpr bool PERM = true, AFTER_DRAIN = false;
    const float* baseP; bf16_t* hb; float* y; const float* gate; int gld; float* slabs;
    __device__ __forceinline__ void operator()(const f32x4 (&acc)[2][2][4][2], const Unit& u, int wr, int wc, int fr, int fq) const {
        if (u.slab >= 0) {
            const __amdgpu_buffer_rsrc_t rs = __builtin_amdgcn_make_buffer_rsrc((void*)slabs, 0, 128 * 262144, 0x00020000);
            const unsigned so_ = (unsigned)(((size_t)u.slab * 65536 + (size_t)(wr * 64 + fr) * 256 + wc * 32 + 8 * fq) * 4);
#pragma unroll
            for (int ai = 0; ai < 2; ++ai)
#pragma unroll
                for (int m = 0; m < 4; ++m)
#pragma unroll
                    for (int bj = 0; bj < 2; ++bj)
#pragma unroll
                        for (int n = 0; n < 2; ++n) wt_store16(rs, so_ + (unsigned)(((ai * HALF + m * 16) * 256 + bj * HALF + n * 4) * 4), __builtin_bit_cast(u32x4, acc[ai][bj][m][n]));
            return;
        }
        const int row0 = u.pm * BM + wr * 64 + fr, col0 = u.pn * BM + wc * 32 + 8 * fq;
        const float* gp = gate + (size_t)(row0 >> 11) * gld + col0;
        f32x4 gv[2][2];
#pragma unroll
        for (int bj = 0; bj < 2; ++bj)
#pragma unroll
            for (int n = 0; n < 2; ++n) gv[bj][n] = *(const f32x4*)(gp + bj * HALF + n * 4);
#pragma unroll
        for (int ai = 0; ai < 2; ++ai)
#pragma unroll
            for (int m = 0; m < 4; ++m) { const int row = row0 + ai * HALF + m * 16; const size_t off = (size_t)row * 1024 + col0;
#pragma unroll
                for (int bj = 0; bj < 2; ++bj) {
                    if (MODE == 0) { const f32x4 b0 = __builtin_nontemporal_load((const f32x4*)(baseP + off + bj * HALF)), b1 = __builtin_nontemporal_load((const f32x4*)(baseP + off + bj * HALF + 4));
                        const f32x4 h0 = b0 + gv[bj][0] * acc[ai][bj][m][0], h1 = b1 + gv[bj][1] * acc[ai][bj][m][1];
                        u32x4 w; w.x = cvt_pk_bf16(h0[0], h0[1]); w.y = cvt_pk_bf16(h0[2], h0[3]); w.z = cvt_pk_bf16(h1[0], h1[1]); w.w = cvt_pk_bf16(h1[2], h1[3]);
                        *(u32x4*)(hb + off + bj * HALF) = w; }
                    else { const u32x4 hw = __builtin_nontemporal_load((const u32x4*)(hb + off + bj * HALF));
                        const f32x4 b0 = (f32x4){__uint_as_float(hw.x << 16), __uint_as_float(hw.x & 0xffff0000u), __uint_as_float(hw.y << 16), __uint_as_float(hw.y & 0xffff0000u)};
                        const f32x4 b1 = (f32x4){__uint_as_float(hw.z << 16), __uint_as_float(hw.z & 0xffff0000u), __uint_as_float(hw.w << 16), __uint_as_float(hw.w & 0xffff0000u)};
                        __builtin_nontemporal_store(b0 + gv[bj][0] * acc[ai][bj][m][0], (f32x4*)(y + off + bj * HALF)); __builtin_nontemporal_store(b1 + gv[bj][1] * acc[ai][bj][m][1], (f32x4*)(y + off + bj * HALF + 4)); }
                } }
    }
};

struct EpiOutNorm {
    static constexpr bool PERM = true, AFTER_DRAIN = false;
    const float* baseP; bf16_t* hb; bf16_t* xn; const float* mod; int gld; const float* n2w; float* xs; unsigned* cnt; PG8_LAS float* lx; float eps;
    __device__ __forceinline__ void operator()(const f32x4 (&acc)[2][2][4][2], const Unit& u, int wr, int wc, int fr, int fq) const {
        asm volatile("" : "+v"(fr), "+v"(fq));
        const int row0 = u.pm * BM + wr * 64 + fr, col0 = u.pn * BM + wc * 32 + 8 * fq;
        const float* mrow = mod + (size_t)(row0 >> 11) * gld;
        f32x4 (&hreg)[2][2][4][2] = const_cast<f32x4 (&)[2][2][4][2]>(acc);
        {
            f32x4 gv[2][2]; u32x4 xq[2][4][2];
#pragma unroll
            for (int bj = 0; bj < 2; ++bj)
#pragma unroll
                for (int n = 0; n < 2; ++n) gv[bj][n] = *(const f32x4*)(mrow + 2048 + col0 + bj * HALF + n * 4);
#pragma unroll
            for (int ai = 0; ai < 2; ++ai)
#pragma unroll
                for (int m = 0; m < 4; ++m)
#pragma unroll
                    for (int bj = 0; bj < 2; ++bj) xq[ai][m][bj] = __builtin_nontemporal_load((const u32x4*)(hb + (size_t)(row0 + ai * HALF + m * 16) * 1024 + col0 + bj * HALF));
#pragma unroll
            for (int ai = 0; ai < 2; ++ai)
#pragma unroll
                for (int m = 0; m < 4; ++m) { const int row = row0 + ai * HALF + m * 16; const size_t off = (size_t)row * 1024 + col0; float ss = 0.f;
#pragma unroll
                    for (int bj = 0; bj < 2; ++bj) {
                        const u32x4 xw = xq[ai][m][bj];
                        const f32x4 b0 = (f32x4){__uint_as_float(xw.x << 16), __uint_as_float(xw.x & 0xffff0000u), __uint_as_float(xw.y << 16), __uint_as_float(xw.y & 0xffff0000u)};
                        const f32x4 b1 = (f32x4){__uint_as_float(xw.z << 16), __uint_as_float(xw.z & 0xffff0000u), __uint_as_float(xw.w << 16), __uint_as_float(xw.w & 0xffff0000u)};
                        const f32x4 h0 = b0 + gv[bj][0] * acc[ai][bj][m][0], h1 = b1 + gv[bj][1] * acc[ai][bj][m][1];
                        hreg[ai][bj][m][0] = h0; hreg[ai][bj][m][1] = h1;
                        ss += (h0[0] * h0[0] + h0[1] * h0[1]) + (h0[2] * h0[2] + h0[3] * h0[3]) + (h1[0] * h1[0] + h1[1] * h1[1]) + (h1[2] * h1[2] + h1[3] * h1[3]);
                        u32x4 w; w.x = cvt_pk_bf16(h0[0], h0[1]); w.y = cvt_pk_bf16(h0[2], h0[3]); w.z = cvt_pk_bf16(h1[0], h1[1]); w.w = cvt_pk_bf16(h1[2], h1[3]);
                        *(u32x4*)(hb + off + bj * HALF) = w; }
                    ss += __shfl_xor(ss, 16); ss += __shfl_xor(ss, 32);
                    if (fq == 0) lx[(ai * HALF + wr * 64 + m * 16 + fr) * 4 + wc] = ss; }
        }
        __syncthreads();
        const int t = threadIdx.x;
        if (t < 256) { const f32x4 p = *(const PG8_LAS f32x4*)(lx + 4 * t);
            __hip_atomic_store(xs + ((size_t)u.pm * 256 + t) * 4 + u.pn, (p[0] + p[1]) + (p[2] + p[3]), __ATOMIC_RELAXED, __HIP_MEMORY_SCOPE_AGENT); }
        cnt_arrive(cnt + 32 * u.pm);
        cnt_wait_nofence(cnt + 32 * u.pm, 32u);
        if (t < 256) { const float* q = xs + ((size_t)u.pm * 256 + t) * 4;
            const float p0 = __hip_atomic_load(q, __ATOMIC_RELAXED, __HIP_MEMORY_SCOPE_AGENT), p1 = __hip_atomic_load(q + 1, __ATOMIC_RELAXED, __HIP_MEMORY_SCOPE_AGENT),
                        p2 = __hip_atomic_load(q + 2, __ATOMIC_RELAXED, __HIP_MEMORY_SCOPE_AGENT), p3 = __hip_atomic_load(q + 3, __ATOMIC_RELAXED, __HIP_MEMORY_SCOPE_AGENT);
            lx[1024 + t] = __builtin_amdgcn_rsqf(((p0 + p1) + (p2 + p3)) * (1.f / 1024.f) + eps); }
        __syncthreads();
#pragma unroll
        for (int bj = 0; bj < 2; ++bj) {
            f32x4 scw[2], shw[2];
#pragma unroll
            for (int n = 0; n < 2; ++n) { const int c = col0 + bj * HALF + n * 4;
                scw[n] = (*(const f32x4*)(mrow + 4096 + c) + 1.f) * *(const f32x4*)(n2w + c); shw[n] = *(const f32x4*)(mrow + 3072 + c); }
#pragma unroll
            for (int ai = 0; ai < 2; ++ai)
#pragma unroll
                for (int m = 0; m < 4; ++m) { const int row = row0 + ai * HALF + m * 16; const size_t off = (size_t)row * 1024 + col0; const float rstd = lx[1024 + ai * HALF + wr * 64 + m * 16 + fr];
                    const f32x4 o0 = hreg[ai][bj][m][0] * rstd * scw[0] + shw[0], o1 = hreg[ai][bj][m][1] * rstd * scw[1] + shw[1];
                    u32x4 w; w.x = cvt_pk_bf16(o0[0], o0[1]); w.y = cvt_pk_bf16(o0[2], o0[3]); w.z = cvt_pk_bf16(o1[0], o1[1]); w.w = cvt_pk_bf16(o1[2], o1[3]);
                    *(u32x4*)(xn + off + bj * HALF) = w; }
        }
    }
};

struct InOrder {
    StaticOrder so; unsigned* cnt;
    __host__ __device__ void init(int M, int N, int G, int c, int K) { so.init(M, N, G, c, K); }
    __host__ __device__ __forceinline__ bool next(int i, Unit& u) const { const long L = (long)i * so.G + so.c; const bool ok = L < so.nwg; so.at(ok ? so.nwg - 1 - (int)L : 0, u); return ok; }
    __device__ __forceinline__ void a_ready(const Unit&) const {}
    __device__ __forceinline__ void done(const Unit& u) const { if (u.pm >= 64) cnt_arrive(cnt + 32 * (u.pm - 64)); }
};
struct OutPOrder {
    int sup, nkt; const unsigned* cnt;
    __host__ __device__ void init(int sup_, int K) { sup = sup_; nkt = K / BK; }
    __host__ __device__ __forceinline__ bool next(int i, Unit& u) const { u.pm = (sup >> 5) * 8 + (sup & 7); u.pn = (sup >> 3) & 3; u.kt0 = 0; u.nkt = nkt; u.slab = -1; return i == 0; }
    __device__ __forceinline__ void a_ready(const Unit& u) const { cnt_wait(cnt + 32 * u.pm, 4u); }
    __device__ __forceinline__ void done(const Unit&) const {}
};
template <int NSPLIT> struct SubOnly {
    int nN, nS, c, nkt; unsigned* cnt;
    __host__ __device__ void init(int N, int c_, int K_) { nN = N / BM; nS = 4 * nN * NSPLIT; c = c_; nkt = K_ / BK; }
    __host__ __device__ __forceinline__ bool next(int i, Unit& u) const {
        const int s = c; const int un = s / NSPLIT, ks = s % NSPLIT;
        u.pm = 64 + un / nN; u.pn = un % nN; u.kt0 = ks * (nkt / NSPLIT); u.nkt = nkt / NSPLIT; u.slab = s;
        return i == 0 && c < nS;
    }
    __device__ __forceinline__ void a_ready(const Unit&) const {}
    __device__ __forceinline__ void done(const Unit& u) const { cnt_arrive(cnt + 32 * (u.pm - 64)); }
};

template <int NSPLIT> struct SplitOrder {
    StaticOrder so; int nP, nS, G, c, nkt;
    __host__ __device__ void init(int N, int G_, int c_, int K_) { so.init(16384, N, G_, c_, K_); nP = so.nwg; nS = 4 * (N / BM) * NSPLIT; G = G_; c = c_; nkt = K_ / BK; }
    __host__ __device__ __forceinline__ bool next(int i, Unit& u) const {
        const int nsub = c < nS ? (nS - c + G - 1) / G : 0; const bool isP = i >= nsub;
        const long L = isP ? (long)(i - nsub) * G + c : 0; const bool okP = L < nP;
        Unit a; so.at(okP ? (int)L : 0, a);
        const int s = isP ? 0 : c + i * G; const int un = s / NSPLIT, ks = s % NSPLIT; const int nN = so.nN;
        u.pm = isP ? a.pm : 64 + un / nN; u.pn = isP ? a.pn : un % nN; u.kt0 = isP ? 0 : ks * (nkt / NSPLIT); u.nkt = isP ? nkt : nkt / NSPLIT; u.slab = isP ? -1 : s;
        return isP ? okP : true;
    }
    __device__ __forceinline__ void a_ready(const Unit&) const {}
    __device__ __forceinline__ void done(const Unit&) const {}
};

struct Ff1Order {
    StaticOrder so; int nP, nS, G, c; unsigned* cnt; const unsigned* cntr;
    __host__ __device__ void init(int N, int G_, int c_, int K_) { so.init(16384, N, G_, c_, K_); nP = so.nwg; nS = 4 * (N / BM); G = G_; c = c_; }
    __host__ __device__ __forceinline__ bool next(int i, Unit& u) const {
        const bool hasS = c < nS; const bool isS = hasS && i == 2;
        const int ip = (hasS && i > 2) ? i - 1 : i;
        const long L = (long)ip * G + c; const bool okP = L < nP; const bool isP = !isS;
        Unit a; so.at(isP && okP ? (int)L : 0, a);
        const int s = isS ? c : 0; const int nN = so.nN;
        u.pm = isP ? a.pm : 64 + s / nN; u.pn = isP ? a.pn : s % nN; u.kt0 = 0; u.nkt = so.nkt; u.slab = -1;
        return isS || okP;
    }
    __device__ __forceinline__ void a_ready(const Unit& u) const { if (u.pm >= 64) cnt_wait(cntr + 32 * (u.pm - 64), 128u); }
    __device__ __forceinline__ void done(const Unit& u) const { cnt_arrive(cnt + 64 * u.pm); }
};
template <> struct SchedDefer<Ff1Order> { static constexpr bool value = true; };
template <int ACT> struct EpiBf16WT {
    static constexpr bool PERM = true, AFTER_DRAIN = false;
    bf16_t* O; int ldc; size_t bytes;
    __device__ __forceinline__ void operator()(const f32x4 (&acc)[2][2][4][2], const Unit& u, int wr, int wc, int fr, int fq) const {
        const __amdgpu_buffer_rsrc_t rs = __builtin_amdgcn_make_buffer_rsrc((void*)O, 0, (int)bytes, 0x00020000);
        const int row0 = u.pm * BM + wr * 64 + fr; const int col0 = u.pn * BM + wc * 32 + 8 * fq;
#pragma unroll
        for (int ai = 0; ai < 2; ++ai)
#pragma unroll
            for (int m = 0; m < 4; ++m) { const unsigned ro = (unsigned)(((size_t)(row0 + ai * HALF + m * 16) * ldc + col0) * 2);
#pragma unroll
                for (int bj = 0; bj < 2; ++bj) { f32x4 v0 = acc[ai][bj][m][0], v1 = acc[ai][bj][m][1];
                    if (ACT == 2) {
#pragma unroll
                        for (int j = 0; j < 4; ++j) { const float a = __builtin_fmaxf(v0[j], 0.f), b = __builtin_fmaxf(v1[j], 0.f); v0[j] = a * a; v1[j] = b * b; } }
                    u32x4 w; w.x = cvt_pk_bf16(v0[0], v0[1]); w.y = cvt_pk_bf16(v0[2], v0[3]); w.z = cvt_pk_bf16(v1[0], v1[1]); w.w = cvt_pk_bf16(v1[2], v1[3]);
                    wt_store16(rs, ro + bj * HALF * 2, w); } }
    }
};
template <int NSPLIT> struct Ff2Order {
    StaticOrder so; int nP, nS, G, c, c0, nkt; const unsigned* cntp; unsigned* cnts;
    __host__ __device__ void init(int N, int G_, int c_, int K_, int c0_) { so.init(16384, N, G_, c_, K_); nP = so.nwg; nS = 4 * (N / BM) * NSPLIT; G = G_; c = c_; c0 = c0_; nkt = K_ / BK; }
    __host__ __device__ __forceinline__ bool next(int i, Unit& u) const {
        const int s = c - c0; const bool hasS = s >= 0 && s < nS;
        const bool isP = hasS ? (i == 1) : (i == 0);
        Unit a; so.at(c, a);
        const int ss = hasS ? s : 0; const int un = ss / NSPLIT, ks = ss % NSPLIT; const int nN = so.nN;
        u.pm = isP ? a.pm : 64 + un / nN; u.pn = isP ? a.pn : un % nN; u.kt0 = isP ? 0 : ks * (nkt / NSPLIT); u.nkt = isP ? nkt : nkt / NSPLIT; u.slab = isP ? -1 : ss;
        return hasS ? (i < 2) : (i == 0);
    }
    __device__ __forceinline__ void a_ready(const Unit& u) const { cnt_wait(cntp + 64 * u.pm, 128u); }
    __device__ __forceinline__ void done(const Unit& u) const { if (u.slab >= 0) cnt_arrive(cnts + 64 * (u.slab / NSPLIT)); }
};
struct AdaSplit { int c;
    __host__ __device__ __forceinline__ bool next(int i, Unit& u) const { u.pm = 0; u.pn = c >> 2; u.kt0 = 4 * (c & 3); u.nkt = 4; u.slab = c; return i == 0 && c < 96; }
    __device__ __forceinline__ void a_ready(const Unit&) const {}
    __device__ __forceinline__ void done(const Unit&) const {}
};
struct AdaRest { int c;
    __host__ __device__ __forceinline__ bool next(int i, Unit& u) const { u.pm = 0; u.pn = 8 + c; u.kt0 = 0; u.nkt = 16; u.slab = -1; return i == 0 && c < 16; }
    __device__ __forceinline__ void a_ready(const Unit&) const {}
    __device__ __forceinline__ void done(const Unit&) const {}
};
struct EpiSlab {
    static constexpr bool PERM = false, AFTER_DRAIN = false;
    float* slabs;
    __device__ __forceinline__ void operator()(const f32x4 (&acc)[2][2][4][2], const Unit& u, int wr, int wc, int fr, int fq) const {
        const __amdgpu_buffer_rsrc_t rs = __builtin_amdgcn_make_buffer_rsrc((void*)slabs, 0, 96 * 262144, 0x00020000);
        const unsigned so_ = (unsigned)(((size_t)u.slab * 65536 + (size_t)(wr * 64 + fr) * 256 + wc * 32 + 4 * fq) * 4);
#pragma unroll
        for (int ai = 0; ai < 2; ++ai)
#pragma unroll
            for (int m = 0; m < 4; ++m)
                if (ai * HALF + wr * 64 + m * 16 < 136) {
#pragma unroll
                for (int bj = 0; bj < 2; ++bj)
#pragma unroll
                    for (int n = 0; n < 2; ++n) wt_store16(rs, so_ + (unsigned)(((ai * HALF + m * 16) * 256 + bj * HALF + n * 16) * 4), __builtin_bit_cast(u32x4, acc[ai][bj][m][n]));
                }
    }
};

template <class Epi, class Sched, bool ALIGN_EPI = false, bool SP2 = false>
__device__ __forceinline__ void gemm_phase(PG8_LAS unsigned char* lds, const Gemm g, const Sched& S, const Epi& E) {
    int tid_ = threadIdx.x; asm volatile("" : "+v"(tid_));
    const int tid = tid_, wid = __builtin_amdgcn_readfirstlane(tid >> 6), lane = tid & 63, wr = wid >> 2, wc = wid & 3, fr = lane & 15, fq = lane >> 4;
    const int K = g.K;
    unsigned voffA[2], voffB[2];
#pragma unroll
    for (int i = 0; i < 2; ++i) { int R, C; stage_rc(tid * 16 + i * 8192, R, C); const int Rb = Epi::PERM ? ((R & ~31) + perm32(R & 31)) : R;
        voffA[i] = (unsigned)(R * g.lda + C) * 2u; voffB[i] = (unsigned)(Rb * g.ldb + C) * 2u; }
    const size_t kstep = (size_t)(BK * 2);
    const int lda = g.lda, ldb = g.ldb;
    const size_t hstepA = (size_t)HALF * lda * 2, hstepB = (size_t)HALF * ldb * 2;
    const size_t tstepA = 2 * hstepA, tstepB = 2 * hstepB;
    const unsigned ldsw = (unsigned)wid * 1024u;
    const int aoff = lds_byte(wr * 64 + fr, fq * 8), boff = lds_byte(wc * 32 + fr, fq * 8);
#define PG8_SA(b, h) (((b) * 2 + (h)) * HTB)
#define PG8_SB(b, h) ((4 + (b) * 2 + (h)) * HTB)
#define PG8_STAGE(bufoff, gbase, voff) do { _Pragma("unroll") for (int _i = 0; _i < 2; ++_i) \
        __builtin_amdgcn_global_load_lds((const unsigned*)((const char*)(gbase) + (voff)[_i]), (PG8_LAS unsigned*)(lds + (bufoff) + ldsw + _i * 8192), 16, 0, 0); } while (0)
#define PG8_LDA(dst, b, h) do { _Pragma("unroll") for (int m = 0; m < 4; ++m) _Pragma("unroll") for (int k = 0; k < 2; ++k) dst[m][k] = *(const PG8_LAS bf16x8*)(lds + PG8_SA(b, h) + aoff + m * 2048 + k * 1024); } while (0)
#define PG8_LDB(dst, b, h) do { _Pragma("unroll") for (int n = 0; n < 2; ++n) _Pragma("unroll") for (int k = 0; k < 2; ++k) dst[n][k] = *(const PG8_LAS bf16x8*)(lds + PG8_SB(b, h) + boff + n * 2048 + k * 1024); } while (0)
#define PG8_MMA(ai, bj, At, Bt) do { __builtin_amdgcn_s_setprio(1); _Pragma("unroll") for (int m = 0; m < 4; ++m) _Pragma("unroll") for (int n = 0; n < 2; ++n) _Pragma("unroll") for (int k = 0; k < 2; ++k) \
        acc[ai][bj][m][n] = __builtin_amdgcn_mfma_f32_16x16x32_bf16(Bt[n][k], At[m][k], acc[ai][bj][m][n], 0, 0, 0); __builtin_amdgcn_s_setprio(0); } while (0)
#define PG8_WAIT_V(n) asm volatile("s_waitcnt vmcnt(" #n ")" ::: "memory")
#define PG8_WAIT_L(n) asm volatile("s_waitcnt lgkmcnt(" #n ")" ::: "memory")
#define PG8_BAR __builtin_amdgcn_s_barrier()
#define PG8_SCHED __builtin_amdgcn_sched_barrier(0)
    Unit cur, nxt; int ui = 0; Unit pend = {0, 0, 0, 0, -1}; bool have_pend = false;
    if (!S.next(0, cur)) return;
    PG8_TS(49);
    f32x4 acc[2][2][4][2];
#pragma unroll
    for (int a = 0; a < 2; ++a)
#pragma unroll
        for (int b = 0; b < 2; ++b)
#pragma unroll
            for (int m = 0; m < 4; ++m)
#pragma unroll
                for (int n = 0; n < 2; ++n) acc[a][b][m][n] = (f32x4){0.f, 0.f, 0.f, 0.f};
    bf16x8 At[4][2], B0[2][2], B1[2][2];
    const char* cA = (const char*)g.A + (size_t)cur.pm * tstepA + (size_t)cur.kt0 * kstep; const char* cB = (const char*)g.Bt + (size_t)cur.pn * tstepB + (size_t)cur.kt0 * kstep;
    S.a_ready(cur);
    if constexpr (SP2) {
        PG8_STAGE(PG8_SB(0, 0), cB, voffB); PG8_STAGE(PG8_SB(0, 1), cB + hstepB, voffB); PG8_STAGE(PG8_SA(0, 0), cA, voffA); PG8_STAGE(PG8_SA(0, 1), cA + hstepA, voffA);
        if (wr == 1) PG8_BAR;
        PG8_WAIT_V(2); PG8_BAR;
        PG8_STAGE(PG8_SB(1, 0), cB + kstep, voffB); PG8_STAGE(PG8_SA(1, 0), cA + kstep, voffA); PG8_STAGE(PG8_SB(1, 1), cB + hstepB + kstep, voffB);
        PG8_WAIT_V(6); PG8_BAR;
    } else {
        PG8_STAGE(PG8_SB(0, 0), cB, voffB); PG8_STAGE(PG8_SA(0, 0), cA, voffA); PG8_STAGE(PG8_SB(0, 1), cB + hstepB, voffB); PG8_STAGE(PG8_SA(0, 1), cA + hstepA, voffA);
        if (wr == 1) PG8_BAR;
        PG8_WAIT_V(4); PG8_BAR;
        PG8_STAGE(PG8_SB(1, 0), cB + kstep, voffB); PG8_STAGE(PG8_SA(1, 0), cA + kstep, voffA); PG8_STAGE(PG8_SB(1, 1), cB + hstepB + kstep, voffB);
        PG8_WAIT_V(6); PG8_BAR;
    }
    for (;;) {
        const bool has_next = S.next(ui + 1, nxt);
        const char* nA = has_next ? (const char*)g.A + (size_t)nxt.pm * tstepA + (size_t)nxt.kt0 * kstep : cA; const char* nB = has_next ? (const char*)g.Bt + (size_t)nxt.pn * tstepB + (size_t)nxt.kt0 * kstep : cB;
        const int nt = cur.nkt;
        for (int t = 0; t < nt; t += 2) {
            const bool last = (t == nt - 2);
            const char* a1 = cA + (size_t)(t + 1) * kstep;
            const char* a2 = last ? nA : cA + (size_t)(t + 2) * kstep; const char* b2 = last ? nB : cB + (size_t)(t + 2) * kstep;
            const char* a3 = a2 + kstep; const char* b3 = b2 + kstep;
            if (last && has_next) S.a_ready(nxt);
            if constexpr (SP2) {
            PG8_LDB(B0, 0, 0); PG8_LDB(B1, 0, 1); PG8_SCHED; PG8_LDA(At, 0, 0); PG8_STAGE(PG8_SA(1, 1), a1 + hstepA, voffA);
            PG8_WAIT_V(8); PG8_WAIT_L(0); PG8_BAR; PG8_MMA(0, 0, At, B0); PG8_MMA(0, 1, At, B1); PG8_BAR; PG8_SCHED;
            PG8_LDA(At, 0, 1); PG8_STAGE(PG8_SB(0, 0), b2, voffB); PG8_STAGE(PG8_SB(0, 1), b2 + hstepB, voffB); PG8_STAGE(PG8_SA(0, 0), a2, voffA);
            PG8_WAIT_V(8); PG8_WAIT_L(0); PG8_BAR; PG8_MMA(1, 0, At, B0); PG8_MMA(1, 1, At, B1); PG8_BAR; PG8_SCHED;
            PG8_LDB(B0, 1, 0); PG8_LDB(B1, 1, 1); PG8_SCHED; PG8_LDA(At, 1, 0); PG8_STAGE(PG8_SA(0, 1), a2 + hstepA, voffA);
            PG8_WAIT_V(8); PG8_WAIT_L(0); PG8_BAR; PG8_MMA(0, 0, At, B0); PG8_MMA(0, 1, At, B1); PG8_BAR; PG8_SCHED;
            PG8_LDA(At, 1, 1); PG8_STAGE(PG8_SB(1, 0), b3, voffB); PG8_STAGE(PG8_SB(1, 1), b3 + hstepB, voffB); PG8_STAGE(PG8_SA(1, 0), a3, voffA);
            PG8_WAIT_V(8); PG8_WAIT_L(0); PG8_BAR; PG8_MMA(1, 0, At, B0); PG8_MMA(1, 1, At, B1); PG8_BAR; PG8_SCHED;
            } else {
            PG8_LDB(B0, 0, 0); PG8_SCHED; PG8_LDA(At, 0, 0); PG8_STAGE(PG8_SA(1, 1), a1 + hstepA, voffA);
            PG8_WAIT_L(8); PG8_BAR; PG8_WAIT_L(0); PG8_MMA(0, 0, At, B0); PG8_BAR; PG8_SCHED;
            PG8_LDB(B1, 0, 1); PG8_STAGE(PG8_SB(0, 0), b2, voffB);
            PG8_BAR; PG8_WAIT_L(0); PG8_MMA(0, 1, At, B1); PG8_BAR;
            PG8_LDA(At, 0, 1); PG8_STAGE(PG8_SA(0, 0), a2, voffA);
            PG8_BAR; PG8_WAIT_L(0); PG8_MMA(1, 0, At, B0); PG8_BAR; PG8_SCHED;
            PG8_STAGE(PG8_SB(0, 1), b2 + hstepB, voffB);
            PG8_WAIT_V(6); PG8_BAR; PG8_MMA(1, 1, At, B1); PG8_BAR;
            PG8_LDB(B0, 1, 0); PG8_SCHED; PG8_LDA(At, 1, 0); PG8_STAGE(PG8_SA(0, 1), a2 + hstepA, voffA);
            PG8_WAIT_L(8); PG8_BAR; PG8_WAIT_L(0); PG8_MMA(0, 0, At, B0); PG8_BAR; PG8_SCHED;
            PG8_LDB(B1, 1, 1); PG8_STAGE(PG8_SB(1, 0), b3, voffB);
            PG8_BAR; PG8_WAIT_L(0); PG8_MMA(0, 1, At, B1); PG8_BAR;
            PG8_LDA(At, 1, 1); PG8_STAGE(PG8_SA(1, 0), a3, voffA);
            PG8_BAR; PG8_WAIT_L(0); PG8_MMA(1, 0, At, B0); PG8_BAR; PG8_SCHED;
            PG8_STAGE(PG8_SB(1, 1), b3 + hstepB, voffB);
            PG8_WAIT_V(6); PG8_BAR; PG8_MMA(1, 1, At, B1); PG8_BAR;
            }
        }
        if constexpr (ALIGN_EPI) { if (wr == 0) PG8_BAR; }
        PG8_TS(50 + 2 * (ui < 3 ? ui : 3));
        if constexpr (!Epi::AFTER_DRAIN) {
            if constexpr (SchedDefer<Sched>::value) {
                if (have_pend) S.done(pend);
                E(acc, cur, wr, wc, fr, fq);
                if (has_next) { pend = cur; have_pend = true; } else S.done(cur);
            } else { E(acc, cur, wr, wc, fr, fq); S.done(cur); } }
        PG8_TS(51 + 2 * (ui < 3 ? ui : 3));
        if (!has_next) break;
#pragma unroll
        for (int a = 0; a < 2; ++a)
#pragma unroll
            for (int b = 0; b < 2; ++b)
#pragma unroll
                for (int m = 0; m < 4; ++m)
#pragma unroll
                    for (int n = 0; n < 2; ++n) acc[a][b][m][n] = (f32x4){0.f, 0.f, 0.f, 0.f};
        cur = nxt; cA = nA; cB = nB; ++ui;
        if constexpr (ALIGN_EPI) { if (wr == 1) PG8_BAR; }
    }
    PG8_WAIT_V(0);
    if constexpr (!ALIGN_EPI) { if (wr == 0) PG8_BAR; }
    PG8_BAR;
    if constexpr (Epi::AFTER_DRAIN) { E.fused(acc, cur, wr, wc, fr, fq, lds, wid, lane); S.done(cur); }
#undef PG8_SA
#undef PG8_SB
#undef PG8_STAGE
#undef PG8_LDA
#undef PG8_LDB
#undef PG8_MMA
#undef PG8_WAIT_V
#undef PG8_WAIT_L
#undef PG8_BAR
#undef PG8_SCHED
}
}
#define GAS __attribute__((address_space(1)))
#define LAS __attribute__((address_space(3)))
typedef unsigned short bf16;
typedef unsigned v4u __attribute__((ext_vector_type(4)));
typedef float f32x4 __attribute__((ext_vector_type(4)));
typedef short bf16x8 __attribute__((ext_vector_type(8)));
typedef GAS unsigned gu32;
typedef GAS unsigned long long gu64;
#define RLX_AGENT __ATOMIC_RELAXED, __HIP_MEMORY_SCOPE_AGENT
#define LDS_WAIT() asm volatile("s_waitcnt lgkmcnt(0)" ::: "memory")
#define VM_WAIT() asm volatile("s_waitcnt vmcnt(0)" ::: "memory")
__device__ __forceinline__ unsigned long long rt() { return __builtin_amdgcn_s_memrealtime(); }
__device__ __forceinline__ unsigned f2bf(float f) { unsigned u = __builtin_bit_cast(unsigned, f); return (u + 0x7fffu + ((u >> 16) & 1u)) >> 16; }
__device__ __forceinline__ unsigned pk2(float lo, float hi) { return f2bf(lo) | (f2bf(hi) << 16); }

#define XB_TMO      128
#define XB_XCNT(j)  (256  + 64 * (j))
#define XB_XSUB(j)  (1280 + 64 * (j))
#define XB_XGEN(j)  (2304 + 64 * (j))
#define XB_TOP      3328
#define XB_TOPGEN   3392
#define XCD_BAR_WORDS 3456
#define XB_SPIN_CAP (1u << 18)

__device__ __forceinline__ unsigned xb_ld(unsigned* p)              { return __hip_atomic_load(p, __ATOMIC_RELAXED, __HIP_MEMORY_SCOPE_AGENT); }
__device__ __forceinline__ unsigned xb_add(unsigned* p, unsigned v) { return __hip_atomic_fetch_add(p, v, __ATOMIC_RELAXED, __HIP_MEMORY_SCOPE_AGENT); }
__device__ __forceinline__ unsigned xb_xcc_id() { return (unsigned)__builtin_amdgcn_s_getreg((3 << 11) | 20) & 0xFu; }
#define XB_SPIN(cond, bar) do { unsigned _sp = 0; while (cond) { __builtin_amdgcn_s_sleep(1); \
    if ((++_sp & 255u) == 0u) { if (xb_ld(&(bar)[XB_TMO])) break; if (_sp > XB_SPIN_CAP) { atomicAdd(&(bar)[XB_TMO], 1u); break; } } } } while (0)

struct XcdBarrier {
    unsigned* bar; unsigned x;
    volatile LAS unsigned* st;
};

__device__ __forceinline__ XcdBarrier xcd_barrier_post(unsigned* bar, volatile LAS unsigned* st) {
    XcdBarrier b; b.bar = bar; b.x = xb_xcc_id(); b.st = st;
    if (threadIdx.x == 0) (void)xb_add(&bar[XB_XCNT(b.x)], 1u);
    return b;
}
__device__ __forceinline__ void xcd_barrier_complete(unsigned* bar, unsigned x, unsigned& nloc, unsigned& nx) {
    const unsigned G = gridDim.x * gridDim.y * gridDim.z;
    unsigned sum, cnt, mine, sp = 0u;
    for (;;) {
        sum = 0u; cnt = 0u; mine = 0u;
#pragma unroll
        for (unsigned j = 0; j < 16; ++j) { const unsigned c = xb_ld(&bar[XB_XCNT(j)]); sum += c; cnt += (c > 0u) ? 1u : 0u; mine = (j == x) ? c : mine; }
        if (sum == G) break;
        __builtin_amdgcn_s_sleep(1);
        if ((++sp & 255u) == 0u) { if (xb_ld(&bar[XB_TMO])) break; if (sp > XB_SPIN_CAP) { atomicAdd(&bar[XB_TMO], 1u); break; } }
    }
    nloc = mine > 0u ? mine : 1u; nx = cnt > 0u ? cnt : 1u;
}

__device__ __forceinline__ void xcd_barrier(const XcdBarrier& b) {
    asm volatile("s_waitcnt vmcnt(0)" ::: "memory");
    __syncthreads();
    if (threadIdx.x == 0) {
        unsigned* bar = b.bar;
        __builtin_amdgcn_s_waitcnt(0);
        unsigned nloc = b.st[0], nx = b.st[1];
        if (nloc == 0u) { xcd_barrier_complete(bar, b.x, nloc, nx); b.st[0] = nloc; b.st[1] = nx; }
        const unsigned old = xb_add(&bar[XB_XSUB(b.x)], 1u);
        const unsigned gen = old / nloc;
        if (old + 1u == (gen + 1u) * nloc) {
            __builtin_amdgcn_fence(__ATOMIC_RELEASE, "agent");
            asm volatile("s_waitcnt vmcnt(0)" ::: "memory");
            const unsigned og = xb_add(&bar[XB_TOP], 1u);
            const unsigned tg = og / nx;
            if (og + 1u == (tg + 1u) * nx) xb_add(&bar[XB_TOPGEN], 1u);
            else XB_SPIN(xb_ld(&bar[XB_TOPGEN]) == tg, bar);
            __builtin_amdgcn_fence(__ATOMIC_ACQUIRE, "agent");
            xb_add(&bar[XB_XGEN(b.x)], 1u);
            asm volatile("s_waitcnt vmcnt(0)" ::: "memory");
        } else {
            XB_SPIN(xb_ld(&bar[XB_XGEN(b.x)]) == gen, bar);
            __builtin_amdgcn_fence(__ATOMIC_ACQUIRE, "agent");
            asm volatile("s_waitcnt vmcnt(0)" ::: "memory");
        }
    }
    __syncthreads();
}

#define DI __device__ __forceinline__
constexpr int NWAVES = 8;
constexpr int D = 1024, NPR = 16384, NSM = 1024, MTOK = NPR + NSM, NIN = 2320, NINP = 2560, FF = 4096, NADA = 6144;
constexpr int FFP = FF + 64;
constexpr int C_GQ = 0, C_GK = 256, C_GV = 512, C_GR = 1024, C_GLR = 1536, C_SQ = 1552, C_SK = 2064, C_SV = 2192;
constexpr float EPS = 1e-6f;
constexpr float LOG2E = 1.4426950408889634f;
constexpr int NPOS = 2056;
constexpr size_t O_Y = 0, O_STP = 17825792, O_CKP = O_STP + 262144, O_CVP = O_CKP + 131072, O_STS = O_CVP + 131072, O_CKS = O_STS + 4194304, O_CVS = O_CKS + 2097152, O_END = O_CVS + 2097152;
static_assert(O_END == 26738688, "output size");
constexpr size_t MiB = 1u << 20;
constexpr size_t WS_CTL = 0, CTL_ZERO_BYTES = 180224;
constexpr size_t WS_ROPE = 1 * MiB, WS_SC = 2 * MiB, WS_MOD = 3 * MiB, WS_WOUT = 9 * MiB, WS_W1 = 11 * MiB, WS_W2 = 19 * MiB, WS_WIN = 28 * MiB, WS_WADA = 33 * MiB;
constexpr size_t WS_XN = 45 * MiB, WS_PROJ = 79 * MiB, WS_U = 164 * MiB, WS_GD = 172 * MiB, WS_MIX = 173 * MiB, WS_HID = 79 * MiB, WS_HB = 218 * MiB, WS_END = 252 * MiB;
constexpr size_t WS_SLAB_ADA = 173 * MiB;
constexpr size_t WS_SLAB_OUT = 28 * MiB;
constexpr size_t WS_MIXS = 253 * MiB, WS_MIXS_V = WS_MIXS - (size_t)16384 * 1024 * 2;
constexpr size_t WS_SLAB_FF2 = 28 * MiB;
static_assert(WS_W2 + (size_t)D * FFP * 2 <= WS_WIN && WS_WIN + (size_t)NINP * D * 2 <= WS_WADA && WS_SLAB_OUT + (size_t)64 * 262144 <= WS_XN && WS_PROJ + (size_t)MTOK * NINP * 2 <= WS_U && WS_XN + (size_t)MTOK * D * 2 <= WS_PROJ && WS_MIX + (size_t)MTOK * D * 2 <= WS_HB && WS_HID + (size_t)MTOK * FFP * 2 <= WS_HB
              && WS_HB + (size_t)MTOK * D * 2 <= WS_END && WS_SLAB_FF2 + (size_t)64 * 262144 <= WS_XN, "d_ws map");
constexpr int CW_BAR = 4096, CW_CNTA = 24576, CW_CNTP = 32768, CW_CNTS = CW_CNTP + 68 * 64;
constexpr int CW_CNTX = CW_CNTS + 16 * 64, CW_CNTQ = CW_CNTX + 64 * 32;
constexpr int CW_CNTB = CW_CNTQ + 8 * 32;
constexpr int CW_CNTM = CW_CNTB + 32;
constexpr int CW_CNTPS = CW_CNTM + 64 * 32;
static_assert((size_t)(CW_CNTPS + 4 * 32) * 4 <= CTL_ZERO_BYTES, "control words inside the zeroed region");
constexpr size_t WS_XS = 252 * MiB;
static_assert((size_t)(CW_CNTS + 16 * 64) * 4 <= CTL_ZERO_BYTES, "control words inside the zeroed region");
constexpr int RING_OFF = 0, RING_BYTES = 131072, LDSCTL_OFF = RING_BYTES, MISC_OFF = LDSCTL_OFF + 320, LDS_BYTES = 147456;

typedef short s16x4 __attribute__((ext_vector_type(4)));
typedef float f32x16 __attribute__((ext_vector_type(16)));
typedef short v4i16_t __attribute__((ext_vector_type(4)));
typedef unsigned u32x2 __attribute__((ext_vector_type(2)));

DI float bf2f(unsigned short b) { return __uint_as_float((unsigned)b << 16); }
DI float bfs2f(short b) { return __uint_as_float(((unsigned)(unsigned short)b) << 16); }
DI unsigned cvtpk(float lo, float hi) { return pg8::cvt_pk_bf16(lo, hi); }
DI float wave_sum(float v) {
#pragma unroll
    for (int o = 1; o < 64; o <<= 1) v += __shfl_xor(v, o);
    return v;
}
DI int crow(int r, int hi) { return (r & 3) + 8 * (r >> 2) + 4 * hi; }
DI s16x4 trrd(LAS const unsigned char* p) { return __builtin_bit_cast(s16x4, __builtin_amdgcn_ds_read_tr16_b64_v4i16((LAS v4i16_t*)p)); }
DI bf16x8 cat8(s16x4 lo, s16x4 hi) { return (bf16x8){lo[0], lo[1], lo[2], lo[3], hi[0], hi[1], hi[2], hi[3]}; }
DI float silu_f(float v) { return v / (1.f + __expf(-v)); }
DI float logsig_f(float x) { return -(__builtin_fmaxf(-x, 0.f) + __logf(1.f + __expf(-__builtin_fabsf(x)))); }
DI int modrow(int m) { return m < NPR ? (m >> 11) : 8 + ((m - NPR) >> 3); }
DI unsigned kswz(int row, int c) { return (unsigned)(row * 128 + ((c ^ ((row >> 1) & 7)) << 4)); }

struct Frame {
    LAS unsigned char* lds;
    volatile LAS unsigned* MISC;
    gu32* ctl;
    int tid, lane, wave, vcu, G;
    const float* const* in;
    float* out; unsigned char* ws;
    const float* invf;
};
#define IN_XP 0
#define IN_XS 1
#define IN_STATE 2
#define IN_CK 3
#define IN_CV 4
#define IN_CP 5
#define IN_CS 6
#define IN_WADA 7
#define IN_BADA 8
#define IN_N1 9
#define IN_N2 10
#define IN_WIN 11
#define IN_WGU 12
#define IN_BG 13
#define IN_GNW 14
#define IN_QNW 15
#define IN_KNW 16
#define IN_SINK 17
#define IN_WOUT 18
#define IN_WFF1 19
#define IN_WFF2 20

#ifndef INSTR
#define INSTR 0
#endif
#define INSTR_BLOCK 0
#define INSTR_A1 4
#define INSTR_B1 5
#define INSTR_S1 0.01f
#define INSTR_A2 0
#define INSTR_B2 0
#define INSTR_S2 0.0001f
#if INSTR
#define TS(k) do { if ((int)blockIdx.x == INSTR_BLOCK && threadIdx.x == 0) ((unsigned long long*)(F.ws + WS_CTL + 8192))[k] = __builtin_amdgcn_s_memrealtime(); } while (0)
#else
#define TS(k) do { } while (0)
#endif
#if INSTR >= 2
#define TSI(k) TS(k)
#else
#define TSI(k) do { } while (0)
#endif
#if INSTR
#define GTS(p) (((int)blockIdx.x == INSTR_BLOCK && (p) == INSTR_GPHASE) ? (unsigned long long*)(args.ws + WS_CTL + 8192) : nullptr)
#else
#define GTS(p) nullptr
#endif
#define INSTR_GPHASE 8
struct ConvJob { const float* W; int K, N, nb0, nblk; bf16* WT; int ldt; };
template <int NB, bool WT = false>
DI void p0_transpose_batch(const ConvJob (&J)[NB], const int (&item)[NB], const bool (&on)[NB], LAS float* scr, int lane) {
    float tv[NB][32];
#pragma unroll
    for (int b = 0; b < NB; ++b) {
        const int kb = item[b] / J[b].nblk, nb = J[b].nb0 + item[b] % J[b].nblk, k0 = 64 * kb, n0 = 32 * nb; const int nn = n0 + 4 * (lane & 7); const bool ok = on[b] && nn < J[b].N;
#pragma unroll
        for (int i = 0; i < 8; ++i) { const int kk = 8 * i + (lane >> 3);
            const f32x4 v = ok ? __builtin_nontemporal_load((const GAS f32x4*)(J[b].W + (size_t)(k0 + kk) * J[b].N + nn)) : (f32x4){0.f, 0.f, 0.f, 0.f};
            tv[b][4 * i] = v.x; tv[b][4 * i + 1] = v.y; tv[b][4 * i + 2] = v.z; tv[b][4 * i + 3] = v.w; }
    }
#pragma unroll
    for (int b = 0; b < NB; ++b) {
        if (on[b]) {
            const int kb = item[b] / J[b].nblk, nb = J[b].nb0 + item[b] % J[b].nblk, k0 = 64 * kb, n0 = 32 * nb;
#pragma unroll
            for (int i = 0; i < 8; ++i) { const int kk = 8 * i + (lane >> 3);
#pragma unroll
                for (int e = 0; e < 4; ++e) scr[kk * 33 + 4 * (lane & 7) + e] = tv[b][4 * i + e]; }
            LDS_WAIT(); asm volatile("" ::: "memory");
            const int c = lane & 7;
#pragma unroll
            for (int j = 0; j < 4; ++j) { const int n = (lane >> 3) + 8 * j; const LAS float* s = scr + (8 * c) * 33 + n;
                v4u o; o.x = cvtpk(s[0 * 33], s[1 * 33]); o.y = cvtpk(s[2 * 33], s[3 * 33]); o.z = cvtpk(s[4 * 33], s[5 * 33]); o.w = cvtpk(s[6 * 33], s[7 * 33]);
                if (WT) pg8::wt_store16(__builtin_amdgcn_make_buffer_rsrc((void*)J[b].WT, 0, 64 << 20, 0x00020000), (unsigned)(((size_t)(n0 + n) * J[b].ldt + k0 + 8 * c) * 2), o);
                else *(GAS v4u*)(J[b].WT + (size_t)(n0 + n) * J[b].ldt + k0 + 8 * c) = o; }
            LDS_WAIT(); asm volatile("" ::: "memory");
        }
    }
}
DI void conv_set(Frame& F, int set, int wk, int nwk, int trip0 = 0, int trip1 = 1 << 20, int base = 0) {
    LAS float* scr = (LAS float*)(F.lds + RING_OFF + F.wave * 16384);
    bf16* Win_t = (bf16*)(F.ws + WS_WIN); bf16* Wout_t = (bf16*)(F.ws + WS_WOUT); bf16* W1_t = (bf16*)(F.ws + WS_W1); bf16* W2_t = (bf16*)(F.ws + WS_W2); bf16* Wada_t = (bf16*)(F.ws + WS_WADA);
    constexpr int I_ADA = (D / 64) * (NADA / 32), I_IN = (D / 64) * (NINP / 32), I_OUT = (D / 64) * (D / 32), I_1 = (D / 64) * (FF / 32), I_2 = (FF / 64) * (D / 32);
    const ConvJob jAda{F.in[IN_WADA], D, NADA, 0, NADA / 32, Wada_t, D}, jIn{F.in[IN_WIN], D, NIN, 0, NINP / 32, Win_t, D}, jOut{F.in[IN_WOUT], D, D, 0, D / 32, Wout_t, D},
                  j1{F.in[IN_WFF1], D, FF, 0, FF / 32, W1_t, D}, j2{F.in[IN_WFF2], FF, D, 0, D / 32, W2_t, FFP};
    const int total = set == 1 ? I_ADA + I_IN : I_OUT + I_1 + I_2;
#pragma unroll 1
    for (int t = trip0; t < trip1 && base + wk + 2 * t * nwk < total; ++t) {
        const int it0 = base + wk + 2 * t * nwk;
        ConvJob J[2]; int item[2]; bool on[2];
#pragma unroll
        for (int b = 0; b < 2; ++b) { const int it = it0 + b * nwk; on[b] = it < total; const int tt = on[b] ? it : 0;
            if (set == 1) { const bool a = tt < I_ADA; J[b] = a ? jAda : jIn; item[b] = a ? tt : tt - I_ADA; }
            else { const bool a = tt < I_OUT, c = tt < I_OUT + I_1; J[b] = a ? jOut : (c ? j1 : j2); item[b] = a ? tt : (c ? tt - I_OUT : tt - I_OUT - I_1); } }
        if (set == 1) p0_transpose_batch<2, true>(J, item, on, scr, F.lane); else p0_transpose_batch<2, false>(J, item, on, scr, F.lane);
    }
}
DI void front_ada_slice(Frame& F, int c) {
    const int ks = c & 3;
    bf16* SC = (bf16*)(F.ws + WS_SC);
    {   f32x4 cv[17];
#pragma unroll
        for (int i = 0; i < 17; ++i) { const int r = F.wave + 8 * i; const float* src = i == 0 ? F.in[IN_CP] + (size_t)r * D : F.in[IN_CS] + (size_t)(r - 8) * D; cv[i] = *((const GAS f32x4*)(src + 256 * ks) + F.lane); }
#pragma unroll
        for (int i = 0; i < 17; ++i) { const int r = F.wave + 8 * i; const f32x4 v = cv[i];
            *((GAS unsigned long long*)(SC + (size_t)r * D + 256 * ks) + F.lane) = (unsigned long long)cvtpk(silu_f(v.x), silu_f(v.y)) | ((unsigned long long)cvtpk(silu_f(v.z), silu_f(v.w)) << 32); }
    }
    asm volatile("s_waitcnt vmcnt(0)" ::: "memory");
    __syncthreads();
}
DI void front_rope(Frame& F, int wk, int nwk) {
    float* ROPE = (float*)(F.ws + WS_ROPE);
    float invj = 0.f;
#pragma unroll
    for (int jj = 0; jj < 32; ++jj) invj = ((F.lane & 31) == jj) ? F.invf[jj] : invj;
    for (int idx = wk * 64 + F.lane; idx < NPOS * 32; idx += nwk * 64) {
        const int pi = idx >> 5, j = idx & 31; const int pos = pi < 2048 ? pi : 8192 + (pi - 2048);
        const float angf = (float)pos * invj;
        const double a = (double)angf; const double n = __builtin_rint(a * 0.63661977236758134308); const double rr = a - n * 1.57079632679489661923;
        const float x = (float)rr, x2 = x * x;
        const float s = x + x * x2 * (-1.6666654611e-1f + x2 * (8.3321608736e-3f + x2 * (-1.9515295891e-4f)));
        const float c = 1.f - 0.5f * x2 + x2 * x2 * (4.166664568298827e-2f + x2 * (-1.388731625493765e-3f + x2 * 2.443315711809948e-5f));
        const int q = ((int)n) & 3;
        const float sn = (q == 0) ? s : (q == 1) ? c : (q == 2) ? -s : -c;
        const float cs = (q == 0) ? c : (q == 1) ? -s : (q == 2) ? -c : s;
        ROPE[(size_t)pi * 64 + j] = cs; ROPE[(size_t)pi * 64 + 32 + j] = sn;
    }
}

constexpr int NADAWG = 96;
DI void ada_combine(Frame& F, int t, int rb) {
    float* MOD = (float*)(F.ws + WS_MOD); const float* SLA = (const float*)(F.ws + WS_SLAB_ADA); const float* bada = F.in[IN_BADA];
    const int c4 = F.tid & 63; const f32x4 bv = *((const GAS f32x4*)(bada + 256 * t) + c4);
    const int r0 = 32 * rb;
    f32x4 a[4][4];
#pragma unroll
    for (int e = 0; e < 4; ++e) { const int r = r0 + 8 * e + (F.tid >> 6); const int rr = r < 136 ? r : 135;
#pragma unroll
        for (int ks = 0; ks < 4; ++ks) a[e][ks] = *((const GAS f32x4*)(SLA + (size_t)(4 * t + ks) * 65536 + (size_t)rr * 256) + c4); }
#pragma unroll
    for (int e = 0; e < 4; ++e) { const int r = r0 + 8 * e + (F.tid >> 6);
        if (r < 136) *((GAS f32x4*)(MOD + (size_t)r * NADA + 256 * t) + c4) = bv + ((a[e][0] + a[e][1]) + (a[e][2] + a[e][3])); }
}

template <bool SECOND>
DI void nm_stage_mod(Frame& F, int mr_p, int mr_s, int set = 0) {
    const float* nw = SECOND ? F.in[IN_N2] : F.in[IN_N1]; const float* MOD = (const float*)(F.ws + WS_MOD); const float* bada = F.in[IN_BADA]; const float* SLA = (const float*)(F.ws + WS_SLAB_ADA);
    LAS float* L = (LAS float*)(F.lds + RING_OFF) + set * 4096;
    const int which = F.tid >> 8, c4 = F.tid & 255; const int mr = which ? mr_s : mr_p; const int j = c4 >> 6, l4 = c4 & 63;
    f32x4 sh, sc; const f32x4 wn = *((const GAS f32x4*)nw + c4);
    if (SECOND) { sh = *((const GAS f32x4*)(MOD + (size_t)mr * NADA + 3072) + c4); sc = *((const GAS f32x4*)(MOD + (size_t)mr * NADA + 4096) + c4); }
    else { sh = *((const GAS f32x4*)bada + c4); sc = *((const GAS f32x4*)(bada + 1024) + c4);
#pragma unroll
        for (int ks = 0; ks < 4; ++ks) { sh += *(const GAS f32x4*)(SLA + (size_t)(4 * j + ks) * 65536 + (size_t)mr * 256 + 4 * l4); sc += *(const GAS f32x4*)(SLA + (size_t)(4 * (4 + j) + ks) * 65536 + (size_t)mr * 256 + 4 * l4); } }
    *(LAS f32x4*)(L + which * 2048 + 4 * c4) = sh; *(LAS f32x4*)(L + which * 2048 + 1024 + 4 * c4) = (sc + 1.f) * wn;
}
DI void nm_read_mod(Frame& F, int which, f32x4 (&sh)[4], f32x4 (&sc)[4]) {
    LAS const float* L = (LAS const float*)(F.lds + RING_OFF) + which * 2048;
#pragma unroll
    for (int j = 0; j < 4; ++j) { sh[j] = *(LAS const f32x4*)(L + 4 * (F.lane + 64 * j)); sc[j] = *(LAS const f32x4*)(L + 1024 + 4 * (F.lane + 64 * j)); }
}
template <bool SECOND>
DI void nm_load_row(Frame& F, int m, f32x4 (&v)[4]) {
    if (SECOND) { const bf16* HB = (const bf16*)(F.ws + WS_HB);
#pragma unroll
        for (int j = 0; j < 4; ++j) { const u32x2 hw = __builtin_nontemporal_load((const GAS u32x2*)(HB + (size_t)m * D) + F.lane + 64 * j);
            v[j] = (f32x4){__uint_as_float(hw.x << 16), __uint_as_float(hw.x & 0xffff0000u), __uint_as_float(hw.y << 16), __uint_as_float(hw.y & 0xffff0000u)}; } }
    else { const float* src = m < NPR ? F.in[IN_XP] + (size_t)m * D : F.in[IN_XS] + (size_t)(m - NPR) * D;
#pragma unroll
        for (int j = 0; j < 4; ++j) v[j] = __builtin_nontemporal_load((const GAS f32x4*)src + F.lane + 64 * j); }
}
DI void nm_finish_row(Frame& F, int m, const f32x4 (&v)[4], const f32x4 (&sh)[4], const f32x4 (&sc)[4]) {
    float s = 0.f;
#pragma unroll
    for (int j = 0; j < 4; ++j) s += (v[j].x * v[j].x + v[j].y * v[j].y) + (v[j].z * v[j].z + v[j].w * v[j].w);
    const float rstd = __builtin_amdgcn_rsqf(wave_sum(s) * (1.f / D) + EPS);
    GAS unsigned long long* o8 = (GAS unsigned long long*)((bf16*)(F.ws + WS_XN) + (size_t)m * D) + F.lane;
#pragma unroll
    for (int j = 0; j < 4; ++j) { const f32x4 o = v[j] * rstd * sc[j] + sh[j];
        o8[64 * j] = (unsigned long long)cvtpk(o.x, o.y) | ((unsigned long long)cvtpk(o.z, o.w) << 32); }
}
DI void prenorm_rows(Frame& F, int wk, int nwk) {
    bf16* XN = (bf16*)(F.ws + WS_XN);
#pragma unroll 1
    for (int m0 = wk; m0 < MTOK; m0 += 4 * nwk) {
        f32x4 v[4][4];
#pragma unroll
        for (int rr = 0; rr < 4; ++rr) { const int m = m0 + rr * nwk; nm_load_row<false>(F, m < MTOK ? m : m0, v[rr]); }
#pragma unroll
        for (int rr = 0; rr < 4; ++rr) {
            const int m = m0 + rr * nwk; float s = 0.f;
#pragma unroll
            for (int j = 0; j < 4; ++j) s += (v[rr][j].x * v[rr][j].x + v[rr][j].y * v[rr][j].y) + (v[rr][j].z * v[rr][j].z + v[rr][j].w * v[rr][j].w);
            const float rstd = __builtin_amdgcn_rsqf(wave_sum(s) * (1.f / D) + EPS);
            if (m < MTOK) { GAS unsigned long long* o8 = (GAS unsigned long long*)(XN + (size_t)m * D) + F.lane;
#pragma unroll
                for (int j = 0; j < 4; ++j) { const f32x4 o = v[rr][j] * rstd; o8[64 * j] = (unsigned long long)cvtpk(o.x, o.y) | ((unsigned long long)cvtpk(o.z, o.w) << 32); } }
        }
    }
}
DI void nm_apply_row(Frame& F, int m, const f32x4 (&sh)[4], const f32x4 (&sc)[4]) {
    GAS unsigned long long* p8 = (GAS unsigned long long*)((bf16*)(F.ws + WS_XN) + (size_t)m * D) + F.lane;
    unsigned long long w[4];
#pragma unroll
    for (int j = 0; j < 4; ++j) w[j] = p8[64 * j];
#pragma unroll
    for (int j = 0; j < 4; ++j) { const unsigned lo = (unsigned)w[j], hi = (unsigned)(w[j] >> 32);
        const f32x4 v = (f32x4){__uint_as_float(lo << 16), __uint_as_float(lo & 0xffff0000u), __uint_as_float(hi << 16), __uint_as_float(hi & 0xffff0000u)};
        const f32x4 o = v * sc[j] + sh[j];
        p8[64 * j] = (unsigned long long)cvtpk(o.x, o.y) | ((unsigned long long)cvtpk(o.z, o.w) << 32); }
}
DI void norm1_apply_phase(Frame& F) {
    const int wg = F.vcu; const int wv = wg * NWAVES + F.wave; const int m0 = 8 * wv; const bool has_s = wv < 1024; const int ms = NPR + wv;
    nm_stage_mod<false>(F, modrow(64 * wg), modrow(NPR + 8 * (wg < 128 ? wg : 0)));
    __syncthreads();
    f32x4 sh[4], sc[4];
    nm_read_mod(F, 0, sh, sc);
#pragma unroll 4
    for (int r = 0; r < 8; ++r) nm_apply_row(F, m0 + r, sh, sc);
    if (has_s) { nm_read_mod(F, 1, sh, sc); nm_apply_row(F, ms, sh, sc); }
    __syncthreads();
}
DI void nm_store_row(Frame& F, int m, const f32x4 (&v)[4], float rstd, const f32x4 (&sh)[4], const f32x4 (&sc)[4]) {
    GAS unsigned long long* o8 = (GAS unsigned long long*)((bf16*)(F.ws + WS_XN) + (size_t)m * D) + F.lane;
#pragma unroll
    for (int j = 0; j < 4; ++j) { const f32x4 o = v[j] * rstd * sc[j] + sh[j];
        o8[64 * j] = (unsigned long long)cvtpk(o.x, o.y) | ((unsigned long long)cvtpk(o.z, o.w) << 32); }
}
DI float nm_rstd(const f32x4 (&v)[4]) {
    float s = 0.f;
#pragma unroll
    for (int j = 0; j < 4; ++j) s += (v[j].x * v[j].x + v[j].y * v[j].y) + (v[j].z * v[j].z + v[j].w * v[j].w);
    return __builtin_amdgcn_rsqf(wave_sum(s) * (1.f / D) + EPS);
}
DI void nm_store_xb(Frame& F, int m, const f32x4 (&v)[4]) {
    GAS unsigned long long* o8 = (GAS unsigned long long*)((bf16*)(F.ws + WS_HB) + (size_t)m * D) + F.lane;
#pragma unroll
    for (int j = 0; j < 4; ++j) o8[64 * j] = (unsigned long long)cvtpk(v[j].x, v[j].y) | ((unsigned long long)cvtpk(v[j].z, v[j].w) << 32);
}
DI void nm_store_pre(Frame& F, int m, const f32x4 (&v)[4], float rstd) {
    GAS unsigned long long* o8 = (GAS unsigned long long*)((bf16*)(F.ws + WS_XN) + (size_t)m * D) + F.lane;
#pragma unroll
    for (int j = 0; j < 4; ++j) { const f32x4 o = v[j] * rstd; o8[64 * j] = (unsigned long long)cvtpk(o.x, o.y) | ((unsigned long long)cvtpk(o.z, o.w) << 32); }
}
DI int nm_third_row(int pv, int k, int q, bool& is_s, bool& ok) {
    is_s = (k == 2) && q >= 16; ok = !is_s || pv < 128;
    return is_s ? NPR + 8 * pv + (q - 16) : 64 * pv + 24 * k + q;
}
DI void norm1_merged(Frame& F, const unsigned* cntb) {
    const int bx = (int)blockIdx.x;
    if (bx < NADAWG) return;
    const int wg = F.vcu; const int wv = wg * NWAVES + F.wave;
    const int m0 = 8 * wv; const bool has_s = wv < 1024; const int ms = NPR + wv;
    const int idx = bx - NADAWG; constexpr int NTH = 3 * NADAWG, NW = 256 - NADAWG;
    const int nth = idx + NW < NTH ? 2 : 1;
    f32x4 va[8][4], vs[4], sh[4], sc[4]; float rs[8], rss = 0.f;
#pragma unroll
    for (int r = 0; r < 8; ++r) nm_load_row<false>(F, m0 + r, va[r]);
    if (has_s) nm_load_row<false>(F, ms, vs);
#pragma unroll
    for (int r = 0; r < 8; ++r) rs[r] = nm_rstd(va[r]);
    if (has_s) rss = nm_rstd(vs);
#pragma unroll
    for (int r = 0; r < 8; ++r) nm_store_xb(F, m0 + r, va[r]);
#pragma unroll 1
    for (int s3 = 0; s3 < nth; ++s3) {
        const int t = idx + NW * s3, g = t / 3, k = t - 3 * g; const int pv = (g % 8) * (F.G / 8) + g / 8;
        f32x4 v[3][4]; int mm[3]; bool ok[3];
#pragma unroll
        for (int e = 0; e < 3; ++e) { bool is_s; mm[e] = nm_third_row(pv, k, 3 * F.wave + e, is_s, ok[e]); nm_load_row<false>(F, ok[e] ? mm[e] : m0, v[e]); }
#pragma unroll
        for (int e = 0; e < 3; ++e) { const float q = nm_rstd(v[e]); if (ok[e]) { nm_store_pre(F, mm[e], v[e], q); if (mm[e] < NPR) nm_store_xb(F, mm[e], v[e]); } }
    }
    pg8::cnt_wait(cntb, 32u);
    nm_stage_mod<false>(F, modrow(64 * wg), modrow(NPR + 8 * (wg < 128 ? wg : 0)));
#pragma unroll 1
    for (int s3 = 0; s3 < nth; ++s3) { const int t = idx + NW * s3, g = t / 3; const int pv = (g % 8) * (F.G / 8) + g / 8;
        nm_stage_mod<false>(F, modrow(64 * pv), modrow(NPR + 8 * (pv < 128 ? pv : 0)), 1 + s3); }
    __syncthreads();
    nm_read_mod(F, 0, sh, sc);
#pragma unroll
    for (int r = 0; r < 8; ++r) nm_store_row(F, m0 + r, va[r], rs[r], sh, sc);
    if (has_s) { nm_read_mod(F, 1, sh, sc); nm_store_row(F, ms, vs, rss, sh, sc); }
#pragma unroll 1
    for (int s3 = 0; s3 < nth; ++s3) {
        const int t = idx + NW * s3, g = t / 3, k = t - 3 * g; const int pv = (g % 8) * (F.G / 8) + g / 8;
        unsigned long long w[3][4]; int mm[3]; bool is_s[3], ok[3];
#pragma unroll
        for (int e = 0; e < 3; ++e) { mm[e] = nm_third_row(pv, k, 3 * F.wave + e, is_s[e], ok[e]);
            const GAS unsigned long long* p8 = (const GAS unsigned long long*)((const bf16*)(F.ws + WS_XN) + (size_t)(ok[e] ? mm[e] : m0) * D) + F.lane;
#pragma unroll
            for (int j = 0; j < 4; ++j) w[e][j] = p8[64 * j]; }
#pragma unroll
        for (int e = 0; e < 3; ++e) {
            nm_read_mod(F, 2 * (1 + s3) + (is_s[e] ? 1 : 0), sh, sc);
            if (ok[e]) { GAS unsigned long long* p8 = (GAS unsigned long long*)((bf16*)(F.ws + WS_XN) + (size_t)mm[e] * D) + F.lane;
#pragma unroll
                for (int j = 0; j < 4; ++j) { const unsigned lo = (unsigned)w[e][j], hi = (unsigned)(w[e][j] >> 32);
                    const f32x4 v = (f32x4){__uint_as_float(lo << 16), __uint_as_float(lo & 0xffff0000u), __uint_as_float(hi << 16), __uint_as_float(hi & 0xffff0000u)};
                    const f32x4 o = v * sc[j] + sh[j];
                    p8[64 * j] = (unsigned long long)cvtpk(o.x, o.y) | ((unsigned long long)cvtpk(o.z, o.w) << 32); } }
        }
    }
    __syncthreads();
}
template <bool SECOND>
DI void normmod_phase(Frame& F) {
    const float* MOD = (const float*)(F.ws + WS_MOD); const float* SLO = (const float*)(F.ws + WS_SLAB_OUT); bf16* HB = (bf16*)(F.ws + WS_HB);
    { const int wg = F.vcu;
        const int wv = wg * NWAVES + F.wave;
        const int m0 = 8 * wv; const bool has_s = wv < 1024; const int ms = NPR + wv;
        f32x4 va[4][4], vs[4], sh[4], sc[4];
#pragma unroll
        for (int r = 0; r < 4; ++r) nm_load_row<SECOND>(F, m0 + r, va[r]);
        nm_stage_mod<SECOND>(F, modrow(64 * wg), modrow(NPR + 8 * (wg < 128 ? wg : 0)));
        __syncthreads();
        nm_read_mod(F, 0, sh, sc);
#pragma unroll
        for (int r = 0; r < 4; ++r) nm_finish_row(F, m0 + r, va[r], sh, sc);
#pragma unroll
        for (int r = 0; r < 4; ++r) nm_load_row<SECOND>(F, m0 + 4 + r, va[r]);
        if (has_s) nm_load_row<false>(F, ms, vs);
#pragma unroll
        for (int r = 0; r < 4; ++r) nm_finish_row(F, m0 + 4 + r, va[r], sh, sc);
        if (has_s) {
            const int mr = modrow(ms);
            nm_read_mod(F, 1, sh, sc);
            if (SECOND) {
                const float* SL = SLO + (size_t)(((ms - NPR) >> 8) * 16) * 65536 + (size_t)(ms & 255) * 256 + 4 * F.lane;
                const GAS f32x4* g1r = (const GAS f32x4*)(MOD + (size_t)mr * NADA + 2048) + F.lane;
#pragma unroll
                for (int j = 0; j < 4; ++j) { f32x4 a = *(const GAS f32x4*)(SL + (size_t)(4 * j) * 65536);
#pragma unroll
                    for (int ks = 1; ks < 4; ++ks) a += *(const GAS f32x4*)(SL + (size_t)(4 * j + ks) * 65536);
                    vs[j] = vs[j] + g1r[64 * j] * a;
                    *((GAS u32x2*)(HB + (size_t)ms * D) + F.lane + 64 * j) = (u32x2){cvtpk(vs[j].x, vs[j].y), cvtpk(vs[j].z, vs[j].w)}; }
            }
            nm_finish_row(F, ms, vs, sh, sc);
        }
        __syncthreads();
    }
}

DI void norm2_sample(Frame& F, int q, const unsigned* cntq, unsigned* cntr) {
    const float* MOD = (const float*)(F.ws + WS_MOD); const float* SLO = (const float*)(F.ws + WS_SLAB_OUT);
    const int p = q >> 4;
    const int ms0 = NPR + 16 * q + 2 * F.wave;
    const int mrA = modrow(NPR + 16 * q), mrB = mrA + 1; const int which = F.wave >> 2; const int mr = which ? mrB : mrA;
    f32x4 vs[2][4], sh[4], sc[4];
#pragma unroll
    for (int e = 0; e < 2; ++e) nm_load_row<false>(F, ms0 + e, vs[e]);
    nm_stage_mod<true>(F, mrA, mrB);
    __syncthreads();
    TS(41);
    pg8::cnt_wait(cntq + 32 * p, 128u);
    TS(42);
    nm_read_mod(F, which, sh, sc);
    const __amdgpu_buffer_rsrc_t rsH = __builtin_amdgcn_make_buffer_rsrc((void*)(F.ws + WS_HB), 0, MTOK * D * 2, 0x00020000), rsX = __builtin_amdgcn_make_buffer_rsrc((void*)(F.ws + WS_XN), 0, MTOK * D * 2, 0x00020000);
    const GAS f32x4* g1r = (const GAS f32x4*)(MOD + (size_t)mr * NADA + 2048) + F.lane;
#pragma unroll
    for (int e = 0; e < 2; ++e) { const int ms = ms0 + e;
        const float* SL = SLO + (size_t)(p * 16) * 65536 + (size_t)(ms & 255) * 256 + 4 * F.lane;
        float s = 0.f;
#pragma unroll
        for (int j = 0; j < 4; ++j) { const f32x4 a = (*(const GAS f32x4*)(SL + (size_t)(4 * j) * 65536) + *(const GAS f32x4*)(SL + (size_t)(4 * j + 1) * 65536))
                                                      + (*(const GAS f32x4*)(SL + (size_t)(4 * j + 2) * 65536) + *(const GAS f32x4*)(SL + (size_t)(4 * j + 3) * 65536));
            vs[e][j] = vs[e][j] + g1r[64 * j] * a;
            __builtin_amdgcn_raw_buffer_store_b64((u32x2){cvtpk(vs[e][j].x, vs[e][j].y), cvtpk(vs[e][j].z, vs[e][j].w)}, rsH, (int)(((size_t)ms * D + 4 * (F.lane + 64 * j)) * 2), 0, 16);
            s += (vs[e][j].x * vs[e][j].x + vs[e][j].y * vs[e][j].y) + (vs[e][j].z * vs[e][j].z + vs[e][j].w * vs[e][j].w); }
        const float rstd = __builtin_amdgcn_rsqf(wave_sum(s) * (1.f / D) + EPS);
#pragma unroll
        for (int j = 0; j < 4; ++j) { const f32x4 o = vs[e][j] * rstd * sc[j] + sh[j];
            __builtin_amdgcn_raw_buffer_store_b64((u32x2){cvtpk(o.x, o.y), cvtpk(o.z, o.w)}, rsX, (int)(((size_t)ms * D + 4 * (F.lane + 64 * j)) * 2), 0, 16); }
    }
    pg8::cnt_arrive(cntr + 32 * p);
    __syncthreads();
}

DI void swa_tile(const bf16x8 (&qf)[4], LAS const unsigned char* Ks, LAS const unsigned char* Vs, LAS float* stg, int kt0, int ktmin, int thr, float sink2, float (&ov)[32], int lane) {
    const int r = lane & 31, h = lane >> 5;
    f32x16 p[5];
#pragma unroll
    for (int kt = 0; kt < 5; ++kt) {
        f32x16 acc;
        if (kt0 + kt >= ktmin) {
#pragma unroll
            for (int i = 0; i < 16; ++i) acc[i] = 0.f;
            const int key = 32 * (kt0 + kt) + r;
#pragma unroll
            for (int s = 0; s < 4; ++s) { const bf16x8 a = *(LAS const bf16x8*)(Ks + kswz(key, 2 * s + h)); acc = __builtin_amdgcn_mfma_f32_32x32x16_bf16(a, qf[s], acc, 0, 0, 0); }
            if (kt == 0) {
#pragma unroll
                for (int i = 0; i < 16; ++i) acc[i] = (crow(i, h) > thr) ? acc[i] : -INFINITY; }
            if (kt == 4) {
#pragma unroll
                for (int i = 0; i < 16; ++i) acc[i] = (crow(i, h) <= thr) ? acc[i] : -INFINITY; }
        } else {
#pragma unroll
            for (int i = 0; i < 16; ++i) acc[i] = -INFINITY; }
        p[kt] = acc;
    }
    float mx = sink2;
#pragma unroll
    for (int kt = 0; kt < 5; ++kt)
#pragma unroll
        for (int i = 0; i < 16; ++i) mx = __builtin_fmaxf(mx, p[kt][i]);
    mx = __builtin_fmaxf(mx, __shfl_xor(mx, 32));
    float l = 0.f;
#pragma unroll
    for (int kt = 0; kt < 5; ++kt)
#pragma unroll
        for (int i = 0; i < 16; ++i) { const float e = __builtin_amdgcn_exp2f(p[kt][i] - mx); p[kt][i] = e; l += e; }
    l += __shfl_xor(l, 32); l += __builtin_amdgcn_exp2f(sink2 - mx);
    f32x16 o[2];
#pragma unroll
    for (int i = 0; i < 16; ++i) { o[0][i] = 0.f; o[1][i] = 0.f; }
    const int q4 = (lane & 15) >> 2, p4 = lane & 3, blk = (lane >> 4) & 1;
#pragma unroll
    for (int kt = 0; kt < 5; ++kt) {
        if (kt0 + kt >= ktmin) {
#pragma unroll
            for (int s2 = 0; s2 < 2; ++s2) {
                v4u w; w.x = cvtpk(p[kt][8 * s2 + 0], p[kt][8 * s2 + 1]); w.y = cvtpk(p[kt][8 * s2 + 2], p[kt][8 * s2 + 3]); w.z = cvtpk(p[kt][8 * s2 + 4], p[kt][8 * s2 + 5]); w.w = cvtpk(p[kt][8 * s2 + 6], p[kt][8 * s2 + 7]);
                const bf16x8 pa = __builtin_bit_cast(bf16x8, w);
                const int krow0 = 32 * (kt0 + kt) + 16 * s2 + 4 * h + q4;
#pragma unroll
                for (int dh = 0; dh < 2; ++dh) {
                    LAS const unsigned char* a0 = Vs + krow0 * 128 + (32 * dh + 16 * blk + 4 * p4) * 2;
                    const s16x4 lo = trrd(a0), hi = trrd(a0 + 8 * 128);
                    o[dh] = __builtin_amdgcn_mfma_f32_32x32x16_bf16(pa, cat8(lo, hi), o[dh], 0, 0, 0);
                }
            }
        }
    }
#pragma unroll
    for (int dh = 0; dh < 2; ++dh)
#pragma unroll
        for (int i = 0; i < 16; ++i) { const int q = crow(i, h), dd = 32 * dh + r; stg[q * 64 + (((dd >> 2) ^ (q & 15)) << 2) + (dd & 3)] = o[dh][i]; }
    asm volatile("s_waitcnt lgkmcnt(0)" ::: "memory");
    const int row = lane >> 1, half = lane & 1; const float rl = 1.f / __shfl(l, row);
#pragma unroll
    for (int k = 0; k < 8; ++k) { const f32x4 x = *(LAS const f32x4*)(stg + row * 64 + (((8 * half + k) ^ (row & 15)) << 2));
        ov[4 * k] = x.x * rl; ov[4 * k + 1] = x.y * rl; ov[4 * k + 2] = x.z * rl; ov[4 * k + 3] = x.w * rl; }
    asm volatile("s_waitcnt lgkmcnt(0)" ::: "memory");
}
DI void swa_store_row(bf16* op, const float (&ov)[32]) {
#pragma unroll
    for (int k = 0; k < 4; ++k) { v4u w; w.x = cvtpk(ov[8 * k], ov[8 * k + 1]); w.y = cvtpk(ov[8 * k + 2], ov[8 * k + 3]); w.z = cvtpk(ov[8 * k + 4], ov[8 * k + 5]); w.w = cvtpk(ov[8 * k + 6], ov[8 * k + 7]);
        *(GAS v4u*)(op + 8 * k) = w; }
}
struct QRegs { v4u x[4]; f32x4 cs[4], sn[4]; };
DI void qf_load(QRegs& R, const bf16* qrow, const float* rope_row, int h) {
#pragma unroll
    for (int s = 0; s < 4; ++s) R.x[s] = *(const GAS v4u*)(qrow + 16 * s + 8 * h);
#pragma unroll
    for (int s = 0; s < 2; ++s) { R.cs[2 * s] = *(const GAS f32x4*)(rope_row + 16 * s + 8 * h); R.cs[2 * s + 1] = *(const GAS f32x4*)(rope_row + 16 * s + 8 * h + 4);
        R.sn[2 * s] = *(const GAS f32x4*)(rope_row + 32 + 16 * s + 8 * h); R.sn[2 * s + 1] = *(const GAS f32x4*)(rope_row + 32 + 16 * s + 8 * h + 4); }
}
DI void qf_make(bf16x8 (&qf)[4], const QRegs& R, const f32x4 (&qw)[8]) {
    float x[4][8]; float ss = 0.f;
#pragma unroll
    for (int s = 0; s < 4; ++s) { const bf16x8 v = __builtin_bit_cast(bf16x8, R.x[s]);
#pragma unroll
        for (int j = 0; j < 8; ++j) { x[s][j] = bfs2f(v[j]); ss += x[s][j] * x[s][j]; } }
    ss += __shfl_xor(ss, 32);
    const float rstd = __builtin_amdgcn_rsqf(ss * (1.f / 64.f) + EPS);
#pragma unroll
    for (int s = 0; s < 4; ++s)
#pragma unroll
        for (int j = 0; j < 8; ++j) x[s][j] *= rstd * qw[2 * s + (j >> 2)][j & 3];
    constexpr float QS = 0.125f * LOG2E;
#pragma unroll
    for (int s = 0; s < 2; ++s)
#pragma unroll
        for (int j = 0; j < 8; ++j) { const float c = R.cs[2 * s + (j >> 2)][j & 3], sn = R.sn[2 * s + (j >> 2)][j & 3]; const float a = x[s][j], b = x[s + 2][j];
            x[s][j] = (a * c - b * sn) * QS; x[s + 2][j] = (b * c + a * sn) * QS; }
#pragma unroll
    for (int s = 0; s < 4; ++s) { v4u w; w.x = cvtpk(x[s][0], x[s][1]); w.y = cvtpk(x[s][2], x[s][3]); w.z = cvtpk(x[s][4], x[s][5]); w.w = cvtpk(x[s][6], x[s][7]); qf[s] = __builtin_bit_cast(bf16x8, w); }
}
struct KRegs { v4u a, b; f32x4 c0, c1, s0, s1; };
DI void kt_load(KRegs& R, const bf16* krow, const float* rope_row, int jq) {
    R.a = (v4u){0u, 0u, 0u, 0u}; R.b = R.a;
    if (krow) { R.a = *(const GAS v4u*)(krow + 8 * jq); R.b = *(const GAS v4u*)(krow + 32 + 8 * jq); }
    R.c0 = *(const GAS f32x4*)(rope_row + 8 * jq); R.c1 = *(const GAS f32x4*)(rope_row + 8 * jq + 4); R.s0 = *(const GAS f32x4*)(rope_row + 32 + 8 * jq); R.s1 = *(const GAS f32x4*)(rope_row + 32 + 8 * jq + 4);
}
DI void kt_finish(LAS unsigned char* Ks, int key, int jq, const KRegs& R, const f32x4 (&kw)[4], float* cache_out) {
    float x1[8], x2[8]; float ss = 0.f;
    const bf16x8 v1 = __builtin_bit_cast(bf16x8, R.a), v2 = __builtin_bit_cast(bf16x8, R.b);
#pragma unroll
    for (int e = 0; e < 8; ++e) { x1[e] = bfs2f(v1[e]); x2[e] = bfs2f(v2[e]); ss += x1[e] * x1[e] + x2[e] * x2[e]; }
    ss += __shfl_xor(ss, 1); ss += __shfl_xor(ss, 2);
    const float rstd = __builtin_amdgcn_rsqf(ss * (1.f / 64.f) + EPS);
    float o1[8], o2[8];
#pragma unroll
    for (int e = 0; e < 8; ++e) { const float a = x1[e] * rstd * kw[e >> 2][e & 3], b = x2[e] * rstd * kw[2 + (e >> 2)][e & 3]; const float c = (e < 4 ? R.c0 : R.c1)[e & 3], sn = (e < 4 ? R.s0 : R.s1)[e & 3];
        o1[e] = a * c - b * sn; o2[e] = b * c + a * sn; }
    v4u w1, w2; w1.x = cvtpk(o1[0], o1[1]); w1.y = cvtpk(o1[2], o1[3]); w1.z = cvtpk(o1[4], o1[5]); w1.w = cvtpk(o1[6], o1[7]);
    w2.x = cvtpk(o2[0], o2[1]); w2.y = cvtpk(o2[2], o2[3]); w2.z = cvtpk(o2[4], o2[5]); w2.w = cvtpk(o2[6], o2[7]);
    *(LAS v4u*)(Ks + kswz(key, jq)) = w1; *(LAS v4u*)(Ks + kswz(key, 4 + jq)) = w2;
    if (cache_out) { *(GAS f32x4*)(cache_out + 8 * jq) = (f32x4){o1[0], o1[1], o1[2], o1[3]}; *(GAS f32x4*)(cache_out + 8 * jq + 4) = (f32x4){o1[4], o1[5], o1[6], o1[7]};
        *(GAS f32x4*)(cache_out + 32 + 8 * jq) = (f32x4){o2[0], o2[1], o2[2], o2[3]}; *(GAS f32x4*)(cache_out + 32 + 8 * jq + 4) = (f32x4){o2[4], o2[5], o2[6], o2[7]}; }
}
constexpr int SWA_KS = 0, SWA_VS = 32768, SWA_STG = 65536;

DI void swa_prompt_item(Frame& F, int item) {
    const int b = item >> 5, kvh = (item >> 4) & 1, i = item & 15;
    const bf16* PROJ = (const bf16*)(F.ws + WS_PROJ); bf16* MIX = (bf16*)(F.ws + WS_MIX); const float* ROPE = (const float*)(F.ws + WS_ROPE);
    LAS unsigned char* Ks = F.lds + RING_OFF + SWA_KS; LAS unsigned char* Vs = F.lds + RING_OFF + SWA_VS; LAS float* stg = (LAS float*)(F.lds + RING_OFF + SWA_STG + F.wave * 8192);
    int tid = F.tid; asm volatile("" : "+v"(tid));
    const int lane = tid & 63, r = lane & 31, h = lane >> 5;
    const float* knw = F.in[IN_KNW]; const float* qnw = F.in[IN_QNW];
    const int jq = tid & 3;
    f32x4 kw[4]; kw[0] = *(const GAS f32x4*)(knw + 8 * jq); kw[1] = *(const GAS f32x4*)(knw + 8 * jq + 4); kw[2] = *(const GAS f32x4*)(knw + 32 + 8 * jq); kw[3] = *(const GAS f32x4*)(knw + 32 + 8 * jq + 4);
    KRegs kr[2];
#pragma unroll
    for (int it = 0; it < 2; ++it) { const int key = (tid + 512 * it) >> 2; const int tok = 128 * (i - 1) + key; const bool ok = tok >= 0;
        kt_load(kr[it], ok ? PROJ + (size_t)(b * 2048 + tok) * NINP + C_SK + 64 * kvh : nullptr, ROPE + (size_t)(ok ? tok : 0) * 64, jq); }
    v4u vv[4];
#pragma unroll
    for (int it = 0; it < 4; ++it) { const int id = tid + 512 * it, key = id >> 3, c = id & 7; const int tok = 128 * (i - 1) + key;
        vv[it] = (v4u){0u, 0u, 0u, 0u}; if (tok >= 0) vv[it] = *(const GAS v4u*)(PROJ + (size_t)(b * 2048 + tok) * NINP + C_SV + 64 * kvh + 8 * c); }
#pragma unroll
    for (int it = 0; it < 2; ++it) { const int key = (tid + 512 * it) >> 2;
        float* co = (i == 15 && key >= 128) ? F.out + O_CKP + ((size_t)(b * 128 + (key - 128)) * 2 + kvh) * 64 : nullptr;
        kt_finish(Ks, key, jq, kr[it], kw, co); }
#pragma unroll
    for (int it = 0; it < 4; ++it) { const int id = tid + 512 * it, key = id >> 3, c = id & 7;
        *(LAS v4u*)(Vs + key * 128 + c * 16) = vv[it];
        if (i == 15 && key >= 128) { float* co = F.out + O_CVP + ((size_t)(b * 128 + (key - 128)) * 2 + kvh) * 64 + 8 * c; const bf16x8 v8 = __builtin_bit_cast(bf16x8, vv[it]);
            *(GAS f32x4*)co = (f32x4){bfs2f(v8[0]), bfs2f(v8[1]), bfs2f(v8[2]), bfs2f(v8[3])}; *(GAS f32x4*)(co + 4) = (f32x4){bfs2f(v8[4]), bfs2f(v8[5]), bfs2f(v8[6]), bfs2f(v8[7])}; } }
    QRegs q0;
    { const int tq = F.wave * 2, head = 4 * kvh + (tq >> 2), tokq = 128 * i + 32 * (tq & 3) + r; qf_load(q0, PROJ + (size_t)(b * 2048 + tokq) * NINP + C_SQ + 64 * head, ROPE + (size_t)tokq * 64, h); }
    __syncthreads();
    const int ktmin = (i == 0) ? 4 : 0;
#pragma unroll 1
    for (int qi = 0; qi < 2; ++qi) {
        const int tq = F.wave * 2 + qi, hq = tq >> 2, o = 32 * (tq & 3), head = 4 * kvh + hq;
        bf16x8 qf[4];
        {   f32x4 qw[8];
#pragma unroll
            for (int s = 0; s < 4; ++s) { qw[2 * s] = *(const GAS f32x4*)(qnw + 16 * s + 8 * h); qw[2 * s + 1] = *(const GAS f32x4*)(qnw + 16 * s + 8 * h + 4); }
            qf_make(qf, q0, qw); }
        if (qi == 0) { const int tq1 = tq + 1, head1 = 4 * kvh + (tq1 >> 2), tokq = 128 * i + 32 * (tq1 & 3) + r; qf_load(q0, PROJ + (size_t)(b * 2048 + tokq) * NINP + C_SQ + 64 * head1, ROPE + (size_t)tokq * 64, h); }
        const float sink2 = F.in[IN_SINK][head] * LOG2E;
        float ov[32];
        swa_tile(qf, Ks, Vs, stg, tq & 3, ktmin, r, sink2, ov, lane);
        swa_store_row(MIX + (size_t)(b * 2048 + 128 * i + o + (lane >> 1)) * D + 512 + 64 * head + 32 * (lane & 1), ov);
    }
    __syncthreads();
}
DI void swa_sample_item(Frame& F, int item) {
    const int b = item >> 1, kvh = item & 1;
    const bf16* PROJ = (const bf16*)(F.ws + WS_PROJ); bf16* MIX = (bf16*)(F.ws + WS_MIXS_V); const float* ROPE = (const float*)(F.ws + WS_ROPE);
    LAS unsigned char* Ks = F.lds + RING_OFF + SWA_KS; LAS unsigned char* Vs = F.lds + RING_OFF + SWA_VS; LAS float* stg = (LAS float*)(F.lds + RING_OFF + SWA_STG + F.wave * 8192);
    int tid = F.tid; asm volatile("" : "+v"(tid));
    const int lane = tid & 63, r = lane & 31, h = lane >> 5, jq = tid & 3;
    const float* knw = F.in[IN_KNW]; const float* qnw = F.in[IN_QNW];
    const float* CK = F.in[IN_CK]; const float* CV = F.in[IN_CV];
    f32x4 ck0, ck1, ck2, ck3;
    { const float* src = CK + ((size_t)(b * 128 + (tid >> 2)) * 2 + kvh) * 64; ck0 = __builtin_nontemporal_load((const GAS f32x4*)(src + 8 * jq)); ck1 = __builtin_nontemporal_load((const GAS f32x4*)(src + 8 * jq + 4)); ck2 = __builtin_nontemporal_load((const GAS f32x4*)(src + 32 + 8 * jq)); ck3 = __builtin_nontemporal_load((const GAS f32x4*)(src + 32 + 8 * jq + 4)); }
    f32x4 cv[2][2];
#pragma unroll
    for (int it = 0; it < 2; ++it) { const int id = tid + 512 * it, key = id >> 3, c = id & 7; const float* src = CV + ((size_t)(b * 128 + key) * 2 + kvh) * 64 + 8 * c; cv[it][0] = __builtin_nontemporal_load((const GAS f32x4*)src); cv[it][1] = __builtin_nontemporal_load((const GAS f32x4*)(src + 4)); }
    KRegs kn; f32x4 kw[4]; v4u vn = (v4u){0u, 0u, 0u, 0u};
    const int nkey = 128 + (tid >> 2); const int nt = nkey - 128; const bool nok = nt < 8;
    if (tid < 128) { kw[0] = *(const GAS f32x4*)(knw + 8 * jq); kw[1] = *(const GAS f32x4*)(knw + 8 * jq + 4); kw[2] = *(const GAS f32x4*)(knw + 32 + 8 * jq); kw[3] = *(const GAS f32x4*)(knw + 32 + 8 * jq + 4);
        kt_load(kn, nok ? PROJ + (size_t)(NPR + b * 8 + nt) * NINP + C_SK + 64 * kvh : nullptr, ROPE + (size_t)(2048 + (nok ? nt : 0)) * 64, jq); }
    const int vkey = 128 + (tid >> 3), vc = tid & 7;
    if (tid < 64) vn = *(const GAS v4u*)(PROJ + (size_t)(NPR + b * 8 + (vkey - 128)) * NINP + C_SV + 64 * kvh + 8 * vc);
    QRegs q0; f32x4 qw[8];
    const int hq = r >> 3, t = r & 7, head = 4 * kvh + hq;
    if (F.wave == 0) {
#pragma unroll
        for (int s = 0; s < 4; ++s) { qw[2 * s] = *(const GAS f32x4*)(qnw + 16 * s + 8 * h); qw[2 * s + 1] = *(const GAS f32x4*)(qnw + 16 * s + 8 * h + 4); }
        qf_load(q0, PROJ + (size_t)(NPR + b * 8 + t) * NINP + C_SQ + 64 * head, ROPE + (size_t)(2048 + t) * 64, h); }
    { const int key = tid >> 2;
        v4u w1, w2; w1.x = cvtpk(ck0.x, ck0.y); w1.y = cvtpk(ck0.z, ck0.w); w1.z = cvtpk(ck1.x, ck1.y); w1.w = cvtpk(ck1.z, ck1.w);
        w2.x = cvtpk(ck2.x, ck2.y); w2.y = cvtpk(ck2.z, ck2.w); w2.z = cvtpk(ck3.x, ck3.y); w2.w = cvtpk(ck3.z, ck3.w);
        *(LAS v4u*)(Ks + kswz(key, jq)) = w1; *(LAS v4u*)(Ks + kswz(key, 4 + jq)) = w2;
        if (key >= 8) { float* co = F.out + O_CKS + ((size_t)(b * 128 + (key - 8)) * 2 + kvh) * 64;
            __builtin_nontemporal_store(ck0, (GAS f32x4*)(co + 8 * jq)); __builtin_nontemporal_store(ck1, (GAS f32x4*)(co + 8 * jq + 4)); __builtin_nontemporal_store(ck2, (GAS f32x4*)(co + 32 + 8 * jq)); __builtin_nontemporal_store(ck3, (GAS f32x4*)(co + 32 + 8 * jq + 4)); } }
#pragma unroll
    for (int it = 0; it < 2; ++it) { const int id = tid + 512 * it, key = id >> 3, c = id & 7;
        v4u w; w.x = cvtpk(cv[it][0].x, cv[it][0].y); w.y = cvtpk(cv[it][0].z, cv[it][0].w); w.z = cvtpk(cv[it][1].x, cv[it][1].y); w.w = cvtpk(cv[it][1].z, cv[it][1].w);
        *(LAS v4u*)(Vs + key * 128 + c * 16) = w;
        if (key >= 8) { float* co = F.out + O_CVS + ((size_t)(b * 128 + (key - 8)) * 2 + kvh) * 64 + 8 * c; __builtin_nontemporal_store(cv[it][0], (GAS f32x4*)co); __builtin_nontemporal_store(cv[it][1], (GAS f32x4*)(co + 4)); } }
    if (tid < 128) kt_finish(Ks, nkey, jq, kn, kw, nok ? F.out + O_CKS + ((size_t)(b * 128 + 120 + nt) * 2 + kvh) * 64 : nullptr);
    if (tid < 256) { *(LAS v4u*)(Vs + vkey * 128 + vc * 16) = vn;
        if (tid < 64) { const bf16x8 v8 = __builtin_bit_cast(bf16x8, vn); float* co = F.out + O_CVS + ((size_t)(b * 128 + 120 + (vkey - 128)) * 2 + kvh) * 64 + 8 * vc;
            *(GAS f32x4*)co = (f32x4){bfs2f(v8[0]), bfs2f(v8[1]), bfs2f(v8[2]), bfs2f(v8[3])}; *(GAS f32x4*)(co + 4) = (f32x4){bfs2f(v8[4]), bfs2f(v8[5]), bfs2f(v8[6]), bfs2f(v8[7])}; } }
    __syncthreads();
    if (F.wave == 0) {
        bf16x8 qf[4]; qf_make(qf, q0, qw);
        const float sink2 = F.in[IN_SINK][head] * LOG2E;
        float ov[32];
        swa_tile(qf, Ks, Vs, stg, 0, 0, t, sink2, ov, lane);
        const int row = lane >> 1;
        swa_store_row(MIX + (size_t)(NPR + b * 8 + (row & 7)) * D + 512 + 64 * (4 * kvh + (row >> 3)) + 32 * (lane & 1), ov);
    }
    __syncthreads();
}

struct SwaCache { f32x4 ck[2][4], cv[2][2][2]; };
DI void swa_cache_load(Frame& F, int tid, int itemA, int itemB, SwaCache& C) {
    const float* CK = F.in[IN_CK]; const float* CV = F.in[IN_CV]; const int jq = tid & 3;
#pragma unroll
    for (int p = 0; p < 2; ++p) { const int item = p ? itemB : itemA; const int b = item >> 1, kvh = item & 1;
        { const float* src = CK + ((size_t)(b * 128 + (tid >> 2)) * 2 + kvh) * 64; C.ck[p][0] = __builtin_nontemporal_load((const GAS f32x4*)(src + 8 * jq)); C.ck[p][1] = __builtin_nontemporal_load((const GAS f32x4*)(src + 8 * jq + 4));
          C.ck[p][2] = __builtin_nontemporal_load((const GAS f32x4*)(src + 32 + 8 * jq)); C.ck[p][3] = __builtin_nontemporal_load((const GAS f32x4*)(src + 32 + 8 * jq + 4)); }
#pragma unroll
        for (int it = 0; it < 2; ++it) { const int id = tid + 512 * it, key = id >> 3, c = id & 7; const float* src = CV + ((size_t)(b * 128 + key) * 2 + kvh) * 64 + 8 * c;
            C.cv[p][it][0] = __builtin_nontemporal_load((const GAS f32x4*)src); C.cv[p][it][1] = __builtin_nontemporal_load((const GAS f32x4*)(src + 4)); }
    }
}
template <bool PRE, bool NEXT>
DI void swa_sample_pair(Frame& F, int itemA, int itemB, const unsigned* cntw, unsigned need, SwaCache& C, int nA, int nB, SwaCache& N) {
    const bf16* PROJ = (const bf16*)(F.ws + WS_PROJ); bf16* MIX = (bf16*)(F.ws + WS_MIXS_V); const float* ROPE = (const float*)(F.ws + WS_ROPE);
    int tid = F.tid; asm volatile("" : "+v"(tid));
    const int lane = tid & 63, r = lane & 31, h = lane >> 5, jq = tid & 3;
    const float* knw = F.in[IN_KNW]; const float* qnw = F.in[IN_QNW];
    const float* CK = F.in[IN_CK]; const float* CV = F.in[IN_CV];
    KRegs kn[2]; v4u vn[2]; f32x4 kw[4];
    const int nkey = 128 + (tid >> 2); const int nt = nkey - 128; const bool nok = nt < 8;
    const int vkey = 128 + (tid >> 3), vc = tid & 7;
    if (tid < 128) { kw[0] = *(const GAS f32x4*)(knw + 8 * jq); kw[1] = *(const GAS f32x4*)(knw + 8 * jq + 4); kw[2] = *(const GAS f32x4*)(knw + 32 + 8 * jq); kw[3] = *(const GAS f32x4*)(knw + 32 + 8 * jq + 4); }
    if (!PRE) swa_cache_load(F, tid, itemA, itemB, C);
    pg8::cnt_wait(cntw, need);
#pragma unroll
    for (int p = 0; p < 2; ++p) { const int item = p ? itemB : itemA; const int b = item >> 1, kvh = item & 1;
        vn[p] = (v4u){0u, 0u, 0u, 0u};
        if (tid < 128) kt_load(kn[p], nok ? PROJ + (size_t)(NPR + b * 8 + nt) * NINP + C_SK + 64 * kvh : nullptr, ROPE + (size_t)(2048 + (nok ? nt : 0)) * 64, jq);
        if (tid < 64) vn[p] = *(const GAS v4u*)(PROJ + (size_t)(NPR + b * 8 + (vkey - 128)) * NINP + C_SV + 64 * kvh + 8 * vc);
    }
#pragma unroll
    for (int p = 0; p < 2; ++p) { const int item = p ? itemB : itemA; const int b = item >> 1, kvh = item & 1;
        LAS unsigned char* Ks = F.lds + RING_OFF + p * 49152; LAS unsigned char* Vs = Ks + 20480;
        { const int key = tid >> 2;
            v4u w1, w2; w1.x = cvtpk(C.ck[p][0].x, C.ck[p][0].y); w1.y = cvtpk(C.ck[p][0].z, C.ck[p][0].w); w1.z = cvtpk(C.ck[p][1].x, C.ck[p][1].y); w1.w = cvtpk(C.ck[p][1].z, C.ck[p][1].w);
            w2.x = cvtpk(C.ck[p][2].x, C.ck[p][2].y); w2.y = cvtpk(C.ck[p][2].z, C.ck[p][2].w); w2.z = cvtpk(C.ck[p][3].x, C.ck[p][3].y); w2.w = cvtpk(C.ck[p][3].z, C.ck[p][3].w);
            *(LAS v4u*)(Ks + kswz(key, jq)) = w1; *(LAS v4u*)(Ks + kswz(key, 4 + jq)) = w2;
            if (key >= 8) { float* co = F.out + O_CKS + ((size_t)(b * 128 + (key - 8)) * 2 + kvh) * 64;
                __builtin_nontemporal_store(C.ck[p][0], (GAS f32x4*)(co + 8 * jq)); __builtin_nontemporal_store(C.ck[p][1], (GAS f32x4*)(co + 8 * jq + 4)); __builtin_nontemporal_store(C.ck[p][2], (GAS f32x4*)(co + 32 + 8 * jq)); __builtin_nontemporal_store(C.ck[p][3], (GAS f32x4*)(co + 32 + 8 * jq + 4)); } }
#pragma unroll
        for (int it = 0; it < 2; ++it) { const int id = tid + 512 * it, key = id >> 3, c = id & 7;
            v4u w; w.x = cvtpk(C.cv[p][it][0].x, C.cv[p][it][0].y); w.y = cvtpk(C.cv[p][it][0].z, C.cv[p][it][0].w); w.z = cvtpk(C.cv[p][it][1].x, C.cv[p][it][1].y); w.w = cvtpk(C.cv[p][it][1].z, C.cv[p][it][1].w);
            *(LAS v4u*)(Vs + key * 128 + c * 16) = w;
            if (key >= 8) { float* co = F.out + O_CVS + ((size_t)(b * 128 + (key - 8)) * 2 + kvh) * 64 + 8 * c; __builtin_nontemporal_store(C.cv[p][it][0], (GAS f32x4*)co); __builtin_nontemporal_store(C.cv[p][it][1], (GAS f32x4*)(co + 4)); } }
        if (tid < 128) kt_finish(Ks, nkey, jq, kn[p], kw, nok ? F.out + O_CKS + ((size_t)(b * 128 + 120 + nt) * 2 + kvh) * 64 : nullptr);
        if (tid < 256) { *(LAS v4u*)(Vs + vkey * 128 + vc * 16) = vn[p];
            if (tid < 64) { const bf16x8 v8 = __builtin_bit_cast(bf16x8, vn[p]); float* co = F.out + O_CVS + ((size_t)(b * 128 + 120 + (vkey - 128)) * 2 + kvh) * 64 + 8 * vc;
                *(GAS f32x4*)co = (f32x4){bfs2f(v8[0]), bfs2f(v8[1]), bfs2f(v8[2]), bfs2f(v8[3])}; *(GAS f32x4*)(co + 4) = (f32x4){bfs2f(v8[4]), bfs2f(v8[5]), bfs2f(v8[6]), bfs2f(v8[7])}; } }
    }
    if (NEXT) swa_cache_load(F, tid, nA, nB, N);
    const int myitem = F.wave == 0 ? itemA : itemB; const int mb = myitem >> 1, mkvh = myitem & 1;
    const int hq = r >> 3, t = r & 7, head = 4 * mkvh + hq;
    QRegs q0; f32x4 qw[8];
    if (F.wave < 2) {
#pragma unroll
        for (int s = 0; s < 4; ++s) { qw[2 * s] = *(const GAS f32x4*)(qnw + 16 * s + 8 * h); qw[2 * s + 1] = *(const GAS f32x4*)(qnw + 16 * s + 8 * h + 4); }
        qf_load(q0, PROJ + (size_t)(NPR + mb * 8 + t) * NINP + C_SQ + 64 * head, ROPE + (size_t)(2048 + t) * 64, h); }
    __syncthreads();
    if (F.wave < 2) {
        LAS unsigned char* Ks = F.lds + RING_OFF + F.wave * 49152; LAS unsigned char* Vs = Ks + 20480; LAS float* stg = (LAS float*)(Ks + 40960);
        bf16x8 qf[4]; qf_make(qf, q0, qw);
        const float sink2 = F.in[IN_SINK][head] * LOG2E;
        float ov[32];
        swa_tile(qf, Ks, Vs, stg, 0, 0, t, sink2, ov, lane);
        const int row = lane >> 1;
        swa_store_row(MIX + (size_t)(NPR + mb * 8 + (row & 7)) * D + 512 + 64 * (4 * mkvh + (row >> 3)) + 32 * (lane & 1), ov);
    }
    __syncthreads();
}

template <int NCH>
DI void gla_gates(Frame& F, LAS const float* GLR, LAS float* TOT, const float (&w)[16], float bg, float (&la)[8 * NCH], float& off, float& total) {
    constexpr int TPT = 8 * NCH, GPC = 8 / NCH;
    const int d = F.tid & 63, g = F.tid >> 6;
    float c = 0.f;
#pragma unroll
    for (int tt = 0; tt < TPT; ++tt) { float gl = bg;
#pragma unroll
        for (int r = 0; r < 16; ++r) gl += GLR[(TPT * g + tt) * 16 + r] * w[r];
        la[tt] = logsig_f(gl) * (1.f / 16.f); c += la[tt]; }
    TOT[g * 64 + d] = c;
    __syncthreads();
    const int g0 = (g / GPC) * GPC; float o_ = 0.f, t_ = 0.f;
#pragma unroll
    for (int gg = 0; gg < GPC; ++gg) { const float v = TOT[(g0 + gg) * 64 + d]; t_ += v; o_ += (g0 + gg < g) ? v : 0.f; }
    off = o_; total = t_;
}
constexpr int GA_GLR = 0, GA_TOT = 16384, GA_GD = 18432, GA_KH = 20480, GA_VS = 53248;
DI void gla_super_a(Frame& F, int sup) {
    const int bh = sup >> 3, j = sup & 7, b = bh >> 2, hh = bh & 3; const int tok0 = b * 2048 + 256 * j;
    const bf16* proj0 = (const bf16*)(F.ws + WS_PROJ) + (size_t)tok0 * NINP;
    LAS unsigned char* L = F.lds + RING_OFF; LAS float* GLR = (LAS float*)(L + GA_GLR); LAS float* TOT = (LAS float*)(L + GA_TOT); LAS float* GDs = (LAS float*)(L + GA_GD);
    LAS unsigned char* KH = L + GA_KH; LAS unsigned char* VS = L + GA_VS;
    int tid = F.tid; asm volatile("" : "+v"(tid));
    const int d = tid & 63, g = tid >> 6;
    {
        const int t = tid >> 1, half = tid & 1; const bf16x8 gv = *(const GAS bf16x8*)(proj0 + (size_t)t * NINP + C_GLR + 8 * half);
        v4u kv[4], vv[8];
#pragma unroll
        for (int it = 0; it < 4; ++it) { const int id = tid + 512 * it; kv[it] = *(const GAS v4u*)(proj0 + (size_t)(id >> 3) * NINP + C_GK + 64 * hh + 8 * (id & 7)); }
#pragma unroll
        for (int it = 0; it < 8; ++it) { const int id = tid + 512 * it; vv[it] = *(const GAS v4u*)(proj0 + (size_t)(id >> 4) * NINP + C_GV + 128 * hh + 8 * (id & 15)); }
#pragma unroll
        for (int jj = 0; jj < 8; ++jj) GLR[t * 16 + 8 * half + jj] = bfs2f(gv[jj]);
#pragma unroll
        for (int it = 0; it < 4; ++it) { const int id = tid + 512 * it; *(LAS v4u*)(KH + (id >> 3) * 128 + (id & 7) * 16) = kv[it]; }
#pragma unroll
        for (int it = 0; it < 8; ++it) { const int id = tid + 512 * it; *(LAS v4u*)(VS + (id >> 4) * 256 + (id & 15) * 16) = vv[it]; }
    }
    float w[16];
#pragma unroll
    for (int r = 0; r < 16; ++r) w[r] = F.in[IN_WGU][r * 256 + 64 * hh + d];
    const float bg = F.in[IN_BG][64 * hh + d];
    __syncthreads();
    float la[32], off, total; gla_gates<4>(F, GLR, TOT, w, bg, la, off, total);
    {   float run = off;
#pragma unroll
        for (int tt = 0; tt < 32; ++tt) { run += la[tt]; LAS unsigned short* kp = (LAS unsigned short*)(KH + (32 * g + tt) * 128 + d * 2);
            *kp = (unsigned short)f2bf(bf2f(*kp) * __expf(total - run)); }
        if ((g & 1) == 0) GDs[(g >> 1) * 64 + d] = __expf(total);
    }
    __syncthreads();
    const int lane = F.lane, h = lane >> 5, q4 = (lane & 15) >> 2, p4 = lane & 3, blk = (lane >> 4) & 1, r = lane & 31;
    const int mt = F.wave >> 2, nt = F.wave & 3;
    f32x16 R;
#pragma unroll
    for (int i = 0; i < 16; ++i) R[i] = 0.f;
#pragma unroll
    for (int c = 0; c < 4; ++c) {
        f32x16 U;
#pragma unroll
        for (int i = 0; i < 16; ++i) U[i] = 0.f;
#pragma unroll
        for (int ks = 0; ks < 4; ++ks) { const int rowb = 64 * c + 16 * ks + 8 * h + q4;
            LAS const unsigned char* pa = KH + rowb * 128 + (32 * mt + 16 * blk + 4 * p4) * 2; LAS const unsigned char* pb = VS + rowb * 256 + (32 * nt + 16 * blk + 4 * p4) * 2;
            U = __builtin_amdgcn_mfma_f32_32x32x16_bf16(cat8(trrd(pa), trrd(pa + 4 * 128)), cat8(trrd(pb), trrd(pb + 4 * 256)), U, 0, 0, 0); }
#pragma unroll
        for (int i = 0; i < 16; ++i) R[i] = GDs[c * 64 + 32 * mt + crow(i, h)] * R[i] + U[i];
    }
    float* T = (float*)(F.ws + WS_U) + (size_t)sup * 8192;
#pragma unroll
    for (int i4 = 0; i4 < 4; ++i4) *(GAS f32x4*)(T + ((F.wave * 4 + i4) * 64 + lane) * 4) = (f32x4){R[4 * i4], R[4 * i4 + 1], R[4 * i4 + 2], R[4 * i4 + 3]};
    if (tid < 64) ((float*)(F.ws + WS_GD))[(size_t)sup * 64 + tid] = (GDs[tid] * GDs[64 + tid]) * (GDs[128 + tid] * GDs[192 + tid]);
    __syncthreads();
}
constexpr int GB_GLR = 0, GB_TOT = 8192, GB_GD = 10240, GB_GP = 10752, GB_QT = 16384, GB_KT = 32768, GB_KH = 49152, GB_VS = 65536, GB_SB = 98304, GB_OB = 16384;
DI f32x4 bufld_f32x4(__amdgpu_buffer_rsrc_t rs, unsigned voff, unsigned soff) { return __builtin_bit_cast(f32x4, __builtin_amdgcn_raw_buffer_load_b128(rs, (int)voff, (int)soff, 0)); }
DI float bufld_f32(__amdgpu_buffer_rsrc_t rs, unsigned voff, unsigned soff) { return __builtin_bit_cast(float, __builtin_amdgcn_raw_buffer_load_b32(rs, (int)voff, (int)soff, 0)); }
struct GlaBRegs { v4u gv, qv[2], kv[2], vv[4], grv[2][2]; };
DI void gla_b_load(GlaBRegs& R, const bf16* proj0, int hh, int tid) {
    R.gv = (v4u){0u, 0u, 0u, 0u}; if (tid < 256) R.gv = *(const GAS v4u*)(proj0 + (size_t)(tid >> 1) * NINP + C_GLR + 8 * (tid & 1));
#pragma unroll
    for (int it = 0; it < 2; ++it) { const int id = tid + 512 * it; R.qv[it] = *(const GAS v4u*)(proj0 + (size_t)(id >> 3) * NINP + C_GQ + 64 * hh + 8 * (id & 7));
        R.kv[it] = *(const GAS v4u*)(proj0 + (size_t)(id >> 3) * NINP + C_GK + 64 * hh + 8 * (id & 7)); }
#pragma unroll
    for (int it = 0; it < 4; ++it) { const int id = tid + 512 * it; R.vv[it] = *(const GAS v4u*)(proj0 + (size_t)(id >> 4) * NINP + C_GV + 128 * hh + 8 * (id & 15)); }
#pragma unroll
    for (int c = 0; c < 2; ++c) { const bf16* grp = proj0 + (size_t)(64 * c + (tid >> 3)) * NINP + C_GR + 128 * hh + 16 * (tid & 7); R.grv[c][0] = *(const GAS v4u*)grp; R.grv[c][1] = *(const GAS v4u*)(grp + 8); }
}
template <bool FIRST>
DI void gla_b_batch(Frame& F, int tid, const GlaBRegs& R, int tokb, int hh, int j, const float (&w)[16], float bg, f32x16& S, f32x16 (&Ta)[3], __amdgpu_buffer_rsrc_t Trs, unsigned tvoff, GlaBRegs& Rn, const bf16* projn) {
    LAS unsigned char* L = F.lds + RING_OFF; LAS float* GLR = (LAS float*)(L + GB_GLR); LAS float* TOT = (LAS float*)(L + GB_TOT); LAS float* GDs = (LAS float*)(L + GB_GD); LAS float* GP = (LAS float*)(L + GB_GP);
    LAS unsigned char* QT = L + GB_QT; LAS unsigned char* KT = L + GB_KT; LAS unsigned char* KH = L + GB_KH; LAS unsigned char* VS = L + GB_VS; LAS unsigned char* SB = L + GB_SB; LAS float* OB = (LAS float*)(L + GB_OB);
    const int d = tid & 63, g = tid >> 6;
    const int lane = tid & 63, r = lane & 31, h = lane >> 5, q4 = (lane & 15) >> 2, p4 = lane & 3, blk = (lane >> 4) & 1;
    const int mt = F.wave >> 2, nt = F.wave & 3;
    if (tid < 256) { const bf16x8 g8 = __builtin_bit_cast(bf16x8, R.gv);
#pragma unroll
        for (int jj = 0; jj < 8; ++jj) GLR[(tid >> 1) * 16 + 8 * (tid & 1) + jj] = bfs2f(g8[jj]); }
#pragma unroll
    for (int it = 0; it < 2; ++it) { const int id = tid + 512 * it; *(LAS v4u*)(QT + kswz(id >> 3, id & 7)) = R.qv[it]; *(LAS v4u*)(KT + kswz(id >> 3, id & 7)) = R.kv[it]; }
#pragma unroll
    for (int it = 0; it < 4; ++it) { const int id = tid + 512 * it; *(LAS v4u*)(VS + (id >> 4) * 256 + (id & 15) * 16) = R.vv[it]; }
    __syncthreads(); TSI(FIRST ? 31 : 41);
    f32x16 Tc[4];
    {
        float la[16], off, total; gla_gates<2>(F, GLR, TOT, w, bg, la, off, total);
        if (FIRST) {
#pragma unroll
            for (int jp = 0; jp < 3; ++jp)
#pragma unroll
                for (int i = 0; i < 16; ++i) S[i] = GP[jp * 64 + 32 * mt + crow(i, h)] * S[i] + Ta[jp][i];
#pragma unroll
            for (int jp = 0; jp < 4; ++jp)
#pragma unroll
                for (int i4 = 0; i4 < 4; ++i4) { const f32x4 tq = (3 + jp < j) ? bufld_f32x4(Trs, tvoff, (unsigned)((3 + jp) * 32768 + i4 * 1024)) : (f32x4){0.f, 0.f, 0.f, 0.f};
                    Tc[jp][4 * i4] = tq.x; Tc[jp][4 * i4 + 1] = tq.y; Tc[jp][4 * i4 + 2] = tq.z; Tc[jp][4 * i4 + 3] = tq.w; }
        }
        float run = off; const float etot = __expf(total);
#pragma unroll
        for (int tt = 0; tt < 16; ++tt) { run += la[tt]; const int tl = 16 * g + tt; const unsigned sw = kswz(tl, d >> 3) + (d & 7) * 2;
            LAS unsigned short* qp = (LAS unsigned short*)(QT + sw); LAS unsigned short* kp = (LAS unsigned short*)(KT + sw);
            const float ep = __expf(run), en = __builtin_amdgcn_rcpf(ep), kk = bf2f(*kp) * en;
            *qp = (unsigned short)f2bf(bf2f(*qp) * 0.125f * ep); *kp = (unsigned short)f2bf(kk);
            *(LAS unsigned short*)(KH + tl * 128 + d * 2) = (unsigned short)f2bf(kk * etot); }
        if ((g & 3) == 0) GDs[(g >> 2) * 64 + d] = etot;
    }
    __syncthreads(); TSI(FIRST ? 32 : 42);
    if (FIRST) {
#pragma unroll
        for (int jp = 0; jp < 4; ++jp)
#pragma unroll
            for (int i = 0; i < 16; ++i) S[i] = GP[(3 + jp) * 64 + 32 * mt + crow(i, h)] * S[i] + Tc[jp][i];
    }
#pragma unroll
    for (int c = 0; c < 2; ++c) {
#pragma unroll
        for (int i = 0; i < 16; ++i) *(LAS unsigned short*)(SB + c * 16384 + (32 * mt + crow(i, h)) * 256 + (32 * nt + r) * 2) = (unsigned short)f2bf(S[i]);
        f32x16 U;
#pragma unroll
        for (int i = 0; i < 16; ++i) U[i] = 0.f;
#pragma unroll
        for (int ks = 0; ks < 4; ++ks) { const int rowb = 64 * c + 16 * ks + 8 * h + q4;
            LAS const unsigned char* pa = KH + rowb * 128 + (32 * mt + 16 * blk + 4 * p4) * 2; LAS const unsigned char* pb = VS + rowb * 256 + (32 * nt + 16 * blk + 4 * p4) * 2;
            U = __builtin_amdgcn_mfma_f32_32x32x16_bf16(cat8(trrd(pa), trrd(pa + 4 * 128)), cat8(trrd(pb), trrd(pb + 4 * 256)), U, 0, 0, 0); }
#pragma unroll
        for (int i = 0; i < 16; ++i) S[i] = GDs[c * 64 + 32 * mt + crow(i, h)] * S[i] + U[i];
    }
    __syncthreads(); TSI(FIRST ? 33 : 43);
    f32x16 o[2];
    const int colb = (32 * nt + 16 * blk + 4 * p4) * 2;
#pragma unroll
    for (int c = 0; c < 2; ++c) {
        bf16x8 qfr[4];
#pragma unroll
        for (int s = 0; s < 4; ++s) qfr[s] = *(LAS const bf16x8*)(QT + kswz(64 * c + 32 * mt + r, 2 * s + h));
#pragma unroll
        for (int i = 0; i < 16; ++i) o[c][i] = 0.f;
#pragma unroll
        for (int st = 0; st < 2; ++st) {
            if (st <= mt) {
                f32x16 pT;
#pragma unroll
                for (int i = 0; i < 16; ++i) pT[i] = 0.f;
#pragma unroll
                for (int s = 0; s < 4; ++s) { const bf16x8 a = *(LAS const bf16x8*)(KT + kswz(64 * c + 32 * st + r, 2 * s + h)); pT = __builtin_amdgcn_mfma_f32_32x32x16_bf16(a, qfr[s], pT, 0, 0, 0); }
                if (st == mt) {
#pragma unroll
                    for (int i = 0; i < 16; ++i) pT[i] = (crow(i, h) > r) ? 0.f : pT[i]; }
#pragma unroll
                for (int s2 = 0; s2 < 2; ++s2) {
                    v4u ww; ww.x = cvtpk(pT[8 * s2 + 0], pT[8 * s2 + 1]); ww.y = cvtpk(pT[8 * s2 + 2], pT[8 * s2 + 3]); ww.z = cvtpk(pT[8 * s2 + 4], pT[8 * s2 + 5]); ww.w = cvtpk(pT[8 * s2 + 6], pT[8 * s2 + 7]);
                    const int rowb = 64 * c + 32 * st + 16 * s2 + 4 * h + q4; LAS const unsigned char* pb = VS + rowb * 256 + colb;
                    o[c] = __builtin_amdgcn_mfma_f32_32x32x16_bf16(__builtin_bit_cast(bf16x8, ww), cat8(trrd(pb), trrd(pb + 8 * 256)), o[c], 0, 0, 0);
                }
            }
        }
#pragma unroll
        for (int s = 0; s < 4; ++s) { const int rowb = 16 * s + 8 * h + q4; LAS const unsigned char* pb = SB + c * 16384 + rowb * 256 + colb;
            o[c] = __builtin_amdgcn_mfma_f32_32x32x16_bf16(qfr[s], cat8(trrd(pb), trrd(pb + 4 * 256)), o[c], 0, 0, 0); }
    }
    if (FIRST) gla_b_load(Rn, projn, hh, tid);
    __syncthreads(); TSI(FIRST ? 34 : 44);
#pragma unroll
    for (int c = 0; c < 2; ++c)
#pragma unroll
        for (int i = 0; i < 16; ++i) OB[c * 8448 + (32 * mt + crow(i, h)) * 132 + 32 * nt + r] = o[c][i];
    __syncthreads();
    {
        const int t = tid >> 3, seg = tid & 7; const float* gnw = F.in[IN_GNW] + 16 * seg;
#pragma unroll
        for (int c = 0; c < 2; ++c) {
            float v[16]; float ss = 0.f;
#pragma unroll
            for (int i = 0; i < 4; ++i) { const f32x4 x = *(LAS const f32x4*)(OB + c * 8448 + t * 132 + 16 * seg + 4 * i); v[4 * i] = x.x; v[4 * i + 1] = x.y; v[4 * i + 2] = x.z; v[4 * i + 3] = x.w; ss += (x.x * x.x + x.y * x.y) + (x.z * x.z + x.w * x.w); }
            ss += __shfl_xor(ss, 1); ss += __shfl_xor(ss, 2); ss += __shfl_xor(ss, 4);
            const float rstd = __builtin_amdgcn_rsqf(ss * (1.f / 128.f) + EPS);
            const bf16x8 g0 = __builtin_bit_cast(bf16x8, R.grv[c][0]), g1 = __builtin_bit_cast(bf16x8, R.grv[c][1]);
            float ov[16];
#pragma unroll
            for (int i = 0; i < 8; ++i) { ov[i] = v[i] * rstd * gnw[i] * silu_f(bfs2f(g0[i])); ov[8 + i] = v[8 + i] * rstd * gnw[8 + i] * silu_f(bfs2f(g1[i])); }
            v4u w0, w1; w0.x = cvtpk(ov[0], ov[1]); w0.y = cvtpk(ov[2], ov[3]); w0.z = cvtpk(ov[4], ov[5]); w0.w = cvtpk(ov[6], ov[7]);
            w1.x = cvtpk(ov[8], ov[9]); w1.y = cvtpk(ov[10], ov[11]); w1.z = cvtpk(ov[12], ov[13]); w1.w = cvtpk(ov[14], ov[15]);
            { const __amdgpu_buffer_rsrc_t rsM = __builtin_amdgcn_make_buffer_rsrc((void*)(F.ws + WS_MIX), 0, MTOK * D * 2, 0x00020000);
              const unsigned bo = (unsigned)(((size_t)(tokb + 64 * c + t) * D + 128 * hh + 16 * seg) * 2); pg8::wt_store16(rsM, bo, w0); pg8::wt_store16(rsM, bo + 16, w1); }
        }
    }
    __syncthreads(); TSI(FIRST ? 35 : 45);
}
DI void gla_super_b(Frame& F, int sup) {
    const int bh = sup >> 3, j = sup & 7, b = bh >> 2, hh = bh & 3;
    LAS float* GP = (LAS float*)(F.lds + RING_OFF + GB_GP);
    int tid = F.tid; asm volatile("" : "+v"(tid));
    const int d = tid & 63;
    const int lane = tid & 63, r = lane & 31, h = lane >> 5;
    const int mt = F.wave >> 2, nt = F.wave & 3;
    const int tok0 = b * 2048 + 256 * j;
    const bf16* proj0 = (const bf16*)(F.ws + WS_PROJ) + (size_t)tok0 * NINP;
    const float* Tb = (const float*)(F.ws + WS_U) + (size_t)(bh * 8) * 8192; const float* Gb = (const float*)(F.ws + WS_GD) + (size_t)(bh * 8) * 64;
    TSI(29);
    GlaBRegs R0; gla_b_load(R0, proj0, hh, tid);
    const __amdgpu_buffer_rsrc_t Trs = __builtin_amdgcn_make_buffer_rsrc((void*)Tb, 0, 8 * 32768, 0x00020000);
    const unsigned tvoff = (unsigned)(F.wave * 4096 + lane * 16);
    f32x16 Ta[3];
#pragma unroll
    for (int jp = 0; jp < 3; ++jp)
#pragma unroll
        for (int i4 = 0; i4 < 4; ++i4) { const f32x4 tq = (jp < j) ? bufld_f32x4(Trs, tvoff, (unsigned)(jp * 32768 + i4 * 1024)) : (f32x4){0.f, 0.f, 0.f, 0.f};
            Ta[jp][4 * i4] = tq.x; Ta[jp][4 * i4 + 1] = tq.y; Ta[jp][4 * i4 + 2] = tq.z; Ta[jp][4 * i4 + 3] = tq.w; }
    GP[tid] = (tid >> 6) < j ? Gb[tid] : 1.f;
    float w[16];
#pragma unroll
    for (int rr = 0; rr < 16; ++rr) w[rr] = F.in[IN_WGU][rr * 256 + 64 * hh + d];
    const float bg = F.in[IN_BG][64 * hh + d];
    f32x16 S;
#pragma unroll
    for (int i = 0; i < 16; ++i) S[i] = 0.f;
    GlaBRegs R1;
    gla_b_batch<true>(F, tid, R0, tok0, hh, j, w, bg, S, Ta, Trs, tvoff, R1, proj0 + (size_t)128 * NINP);
    gla_b_batch<false>(F, tid, R1, tok0 + 128, hh, j, w, bg, S, Ta, Trs, tvoff, R0, proj0);
    if (j == 7) {
        float* So = F.out + O_STP + (size_t)bh * 8192;
#pragma unroll
        for (int i = 0; i < 16; ++i) So[(32 * mt + crow(i, h)) * 128 + 32 * nt + r] = S[i];
    }
}
DI void gla_sample_pair(Frame& F, int item0) {
    LAS float* L = (LAS float*)(F.lds + RING_OFF);
    int tid = F.tid; asm volatile("" : "+v"(tid));
    constexpr int BLK = 11008, O_GLR = 0, O_QS = 128, O_KS = 640, O_KH = 1152, O_GD = 1664, O_AT = 1728, O_VS = 1792, O_S0 = 2816;
    const bf16* PROJ = (const bf16*)(F.ws + WS_PROJ);
    f32x4 s0v[2][4];
#pragma unroll
    for (int u = 0; u < 2; ++u) { const int item = item0 + 256 * u, b = item >> 2, hh = item & 3; const float* S0 = F.in[IN_STATE] + (size_t)(b * 4 + hh) * 8192;
#pragma unroll
        for (int it = 0; it < 4; ++it) s0v[u][it] = __builtin_nontemporal_load((const GAS f32x4*)(S0 + 4 * (tid + 512 * it))); }
    {   const int u = tid >> 8, t2 = tid & 255; const int item = item0 + 256 * u, b = item >> 2, hh = item & 3; const bf16* proj0 = PROJ + (size_t)(NPR + 8 * b) * NINP; LAS float* Lu = L + u * BLK;
        if (t2 < 16) { const int t = t2 >> 1, half = t2 & 1; const bf16x8 v = *(const GAS bf16x8*)(proj0 + (size_t)t * NINP + C_GLR + 8 * half);
#pragma unroll
            for (int j = 0; j < 8; ++j) Lu[O_GLR + t * 16 + 8 * half + j] = bfs2f(v[j]); }
        if (t2 >= 128) { const int t = (t2 - 128) >> 4, c = t2 & 15; const bf16x8 v = *(const GAS bf16x8*)(proj0 + (size_t)t * NINP + C_GV + 128 * hh + 8 * c);
#pragma unroll
            for (int j = 0; j < 8; ++j) Lu[O_VS + t * 128 + 8 * c + j] = bfs2f(v[j]); } }
#pragma unroll
    for (int u = 0; u < 2; ++u)
#pragma unroll
        for (int it = 0; it < 4; ++it) *(LAS f32x4*)(L + u * BLK + O_S0 + 4 * (tid + 512 * it)) = s0v[u][it];
    __syncthreads();
    if (tid < 128) { const int u = tid >> 6, d = tid & 63; const int item = item0 + 256 * u, b = item >> 2, hh = item & 3; const bf16* proj0 = PROJ + (size_t)(NPR + 8 * b) * NINP; LAS float* Lu = L + u * BLK;
        float w[16];
#pragma unroll
        for (int r = 0; r < 16; ++r) w[r] = F.in[IN_WGU][r * 256 + 64 * hh + d];
        const float bg = F.in[IN_BG][64 * hh + d]; float bcl[8]; float c = 0.f;
        float qv[8], kv[8];
#pragma unroll
        for (int t = 0; t < 8; ++t) { qv[t] = bf2f(proj0[(size_t)t * NINP + C_GQ + 64 * hh + d]); kv[t] = bf2f(proj0[(size_t)t * NINP + C_GK + 64 * hh + d]); }
#pragma unroll
        for (int t = 0; t < 8; ++t) { float gl = bg;
#pragma unroll
            for (int r = 0; r < 16; ++r) gl += Lu[O_GLR + t * 16 + r] * w[r];
            c += logsig_f(gl) * (1.f / 16.f); bcl[t] = c; }
#pragma unroll
        for (int t = 0; t < 8; ++t) { const float ep = __expf(bcl[t]);
            Lu[O_QS + t * 64 + d] = qv[t] * 0.125f * ep; Lu[O_KS + t * 64 + d] = kv[t] * __expf(-bcl[t]); Lu[O_KH + t * 64 + d] = kv[t] * __expf(c - bcl[t]); }
        Lu[O_GD + d] = __expf(c);
    }
    __syncthreads();
    if (tid < 128) { const int u = tid >> 6, t = (tid >> 3) & 7, s = tid & 7; LAS float* Lu = L + u * BLK; float a = 0.f;
        for (int d = 0; d < 64; ++d) a += Lu[O_QS + t * 64 + d] * Lu[O_KS + s * 64 + d];
        Lu[O_AT + t * 8 + s] = (s <= t) ? a : 0.f; }
    __syncthreads();
    {   const int t = F.wave, lane = tid & 63; const float* gnw = F.in[IN_GNW];
#pragma unroll
        for (int u = 0; u < 2; ++u) { const int item = item0 + 256 * u, b = item >> 2, hh = item & 3; const bf16* proj0 = PROJ + (size_t)(NPR + 8 * b) * NINP; LAS float* Lu = L + u * BLK;
            const float gr0 = bf2f(proj0[(size_t)t * NINP + C_GR + 128 * hh + lane]), gr1 = bf2f(proj0[(size_t)t * NINP + C_GR + 128 * hh + 64 + lane]);
            float o0 = 0.f, o1 = 0.f;
            for (int d = 0; d < 64; ++d) { const float q = Lu[O_QS + t * 64 + d]; o0 += q * Lu[O_S0 + d * 128 + lane]; o1 += q * Lu[O_S0 + d * 128 + 64 + lane]; }
#pragma unroll
            for (int s = 0; s < 8; ++s) { const float a = Lu[O_AT + t * 8 + s]; o0 += a * Lu[O_VS + s * 128 + lane]; o1 += a * Lu[O_VS + s * 128 + 64 + lane]; }
            const float rstd = __builtin_amdgcn_rsqf(wave_sum(o0 * o0 + o1 * o1) * (1.f / 128.f) + EPS);
            bf16* op = (bf16*)(F.ws + WS_MIXS_V) + (size_t)(NPR + 8 * b + t) * D + 128 * hh;
            op[lane] = (bf16)f2bf(o0 * rstd * gnw[lane] * silu_f(gr0)); op[64 + lane] = (bf16)f2bf(o1 * rstd * gnw[64 + lane] * silu_f(gr1)); }
    }
#pragma unroll
    for (int u = 0; u < 2; ++u) { const int item = item0 + 256 * u, b = item >> 2, hh = item & 3; LAS float* Lu = L + u * BLK; float* So = F.out + O_STS + (size_t)(b * 4 + hh) * 8192;
#pragma unroll
        for (int it = 0; it < 4; ++it) { const int id = tid + 512 * it, d = id >> 5, e4 = id & 31; const f32x4 s0 = *(LAS const f32x4*)(Lu + O_S0 + d * 128 + 4 * e4); f32x4 a = s0 * Lu[O_GD + d];
#pragma unroll
            for (int s = 0; s < 8; ++s) a += *(LAS const f32x4*)(Lu + O_VS + s * 128 + 4 * e4) * Lu[O_KH + s * 64 + d];
            __builtin_nontemporal_store(a, (GAS f32x4*)(So + d * 128 + 4 * e4)); } }
    __syncthreads();
}
DI void slab_reduce_rows(Frame& F, int tile, int r0) {
    const float* MOD = (const float*)(F.ws + WS_MOD); const bf16* HB = (const bf16*)(F.ws + WS_HB);
    const int pm4 = tile >> 2, pn = tile & 3;
#pragma unroll 1
    for (int q0 = 0; q0 < 8; q0 += 4) {
        f32x4 a[4][4]; u32x2 hw[4]; f32x4 g2[4];
#pragma unroll
        for (int q = 0; q < 4; ++q) { const int rr = r0 + 8 * F.wave + q0 + q; const int m = NPR + 256 * pm4 + rr; const int mr = modrow(m);
            const float* SL = (const float*)(F.ws + WS_SLAB_FF2) + (size_t)(tile * 4) * 65536 + (size_t)rr * 256 + 4 * F.lane;
#pragma unroll
            for (int ks = 0; ks < 4; ++ks) a[q][ks] = __builtin_nontemporal_load((const GAS f32x4*)(SL + (size_t)ks * 65536));
            hw[q] = *((const GAS u32x2*)(HB + (size_t)m * D + 256 * pn) + F.lane);
            g2[q] = *((const GAS f32x4*)(MOD + (size_t)mr * NADA + 5120 + 256 * pn) + F.lane); }
#pragma unroll
        for (int q = 0; q < 4; ++q) { const int rr = r0 + 8 * F.wave + q0 + q; const int m = NPR + 256 * pm4 + rr;
            const f32x4 s = (a[q][0] + a[q][1]) + (a[q][2] + a[q][3]);
            const f32x4 hv = (f32x4){__uint_as_float(hw[q].x << 16), __uint_as_float(hw[q].x & 0xffff0000u), __uint_as_float(hw[q].y << 16), __uint_as_float(hw[q].y & 0xffff0000u)};
            __builtin_nontemporal_store(hv + g2[q] * s, (GAS f32x4*)(F.out + O_Y + (size_t)m * D + 256 * pn) + F.lane); }
    }
}

DI bool refresh(Frame& F) { int t = threadIdx.x; asm volatile("" : "+v"(t)); F.tid = t; F.lane = t & 63; return true; }

struct Args { const float* in[21]; float* out; unsigned char* ws; float invf[32]; int ph_lo, ph_hi, li, pad; };
constexpr int N_PHASES = 5;
__global__ void __launch_bounds__(NWAVES * 64, 2) fwd_kernel(Args args) {
    extern __shared__ __attribute__((aligned(16))) unsigned char lds[];
    Frame F;
    F.lds = (LAS unsigned char*)lds;
    F.MISC = (volatile LAS unsigned*)(F.lds + MISC_OFF);
    F.tid = threadIdx.x; F.lane = F.tid & 63; F.wave = __builtin_amdgcn_readfirstlane(F.tid >> 6);
    F.G = gridDim.x; { const int bx = blockIdx.x; F.vcu = (F.G % 8 == 0) ? (bx % 8) * (F.G / 8) + bx / 8 : bx; }
    F.in = args.in; F.out = args.out; F.ws = args.ws; F.invf = args.invf;
    F.ctl = (gu32*)(args.ws + WS_CTL);
    for (int u = F.tid; u < (LDS_BYTES - LDSCTL_OFF) / 4; u += NWAVES * 64) ((LAS unsigned*)(F.lds + LDSCTL_OFF))[u] = 0u;
    __syncthreads();
    if (F.G != 256) return;
    const int lo = args.ph_lo, hi = args.ph_hi;
    const bool multi = (hi - lo) > 1;
    XcdBarrier bar; bar.bar = (unsigned*)(F.ctl + CW_BAR) + args.li * XCD_BAR_WORDS; bar.x = 0; bar.st = nullptr;
    if (multi) bar = xcd_barrier_post((unsigned*)(F.ctl + CW_BAR) + args.li * XCD_BAR_WORDS, F.MISC + 8);
#define IN(k) (lo <= (k) && (k) < hi && refresh(F))
#define SEAM(k) do { if (IN(k) && IN((k) + 1)) xcd_barrier(bar); } while (0)
#define XN ((bf16*)(args.ws + WS_XN))
#define MOD ((float*)(args.ws + WS_MOD))

    enum { PH_FRONT = 0, PH_INPROJ, PH_MIXA, PH_MIXB, PH_FF1, PH_FF2 = 100   };
    TS(0);
    if (IN(PH_FRONT)) {
        unsigned* cnta = (unsigned*)(F.ctl + CW_CNTA);
        const int gw0 = (int)blockIdx.x * NWAVES + F.wave, ngw = F.G * NWAVES;
        if ((int)blockIdx.x < NADAWG) front_ada_slice(F, (int)blockIdx.x);
        conv_set(F, 1, gw0, ngw, 0, 1);
        asm volatile("s_waitcnt vmcnt(0)" ::: "memory"); __syncthreads();
        if (F.tid == 0) __hip_atomic_fetch_add(cnta, 1u, __ATOMIC_RELAXED, __HIP_MEMORY_SCOPE_AGENT);
        if ((int)blockIdx.x < NADAWG) { TSI(12);
            pg8::cnt_wait(cnta, (unsigned)F.G);
            pg8::Gemm g{(const pg8::bf16_t*)(args.ws + WS_SC), (const pg8::bf16_t*)(args.ws + WS_WADA), 256, NADA, D, D, D, nullptr}; pg8::AdaSplit S; S.c = (int)blockIdx.x;
            pg8::EpiSlab E{(float*)(args.ws + WS_SLAB_ADA)};
            pg8::gemm_phase<pg8::EpiSlab, pg8::AdaSplit, true, true>(F.lds + RING_OFF, g, S, E); TSI(13); refresh(F);
            asm volatile("s_waitcnt vmcnt(0)" ::: "memory"); __syncthreads();
            if (F.tid == 0 && (int)blockIdx.x < 32) __hip_atomic_fetch_add((unsigned*)(F.ctl + CW_CNTB), 1u, __ATOMIC_RELAXED, __HIP_MEMORY_SCOPE_AGENT);
            conv_set(F, 2, (int)blockIdx.x * NWAVES + F.wave, NADAWG * NWAVES, 0, 1); }
        else { const int wk = ((int)blockIdx.x - NADAWG) * NWAVES + F.wave, nwk = (F.G - NADAWG) * NWAVES; TSI(12); front_rope(F, wk, nwk); TSI(13); }
        if ((int)blockIdx.x >= NADAWG) {
            const int wk2 = gw0 - NADAWG * NWAVES;
            if (wk2 < 256) { LAS float* scr = (LAS float*)(F.lds + RING_OFF + F.wave * 16384);
                const ConvJob jIn{F.in[IN_WIN], D, NIN, 0, NINP / 32, (bf16*)(F.ws + WS_WIN), D}; ConvJob J[2] = {jIn, jIn}; int item[2] = {4096 + wk2 - (D / 64) * (NADA / 32), 0}; bool on[2] = {true, false};
                p0_transpose_batch<2, false>(J, item, on, scr, F.lane); } }
        __syncthreads(); refresh(F);
        TS(11);
        norm1_merged(F, (const unsigned*)(F.ctl + CW_CNTB));
    } SEAM(PH_FRONT); TS(1); TS(2);
    if (IN(PH_INPROJ)) { { pg8::Gemm g{XN, (const pg8::bf16_t*)(args.ws + WS_WIN), MTOK, NINP, D, D, D, GTS(PH_INPROJ)}; pg8::InOrder S; S.init(MTOK, NINP, F.G, (int)blockIdx.x, D); S.cnt = (unsigned*)(F.ctl + CW_CNTPS);
        pg8::EpiBf16WT<0> E{(pg8::bf16_t*)(args.ws + WS_PROJ), NINP, (size_t)MTOK * NINP * 2};
        pg8::gemm_phase<pg8::EpiBf16WT<0>, pg8::InOrder, true, true>(F.lds + RING_OFF, g, S, E); }
        TS(30);
        const int nfree0 = (MTOK / 256) * (NINP / 256) - 2 * F.G;
        const int cfree = (int)blockIdx.x - nfree0;
        if ((int)blockIdx.x < NADAWG) { refresh(F); conv_set(F, 2, (int)blockIdx.x * NWAVES + F.wave, NADAWG * NWAVES, 1, 2); }
        if (cfree >= 0) { refresh(F);
            if (cfree < 48) { ada_combine(F, 8 + (cfree & 15), cfree >> 4); if (cfree + 48 < 80) ada_combine(F, 8 + ((cfree + 48) & 15), (cfree + 48) >> 4); }
            if (cfree < 48) conv_set(F, 2, cfree * NWAVES + F.wave, 48 * NWAVES, 0, 2, 3072);
            TS(31);
            { const int pr = cfree, pr2 = (F.G - nfree0) + cfree - 48; const bool two = cfree >= 48 && pr2 < 128;
              const unsigned* cps = (const unsigned*)(F.ctl + CW_CNTPS); SwaCache c0, c1; refresh(F);
              if (two) { TS(32); swa_sample_pair<false, true>(F, 2 * pr, 2 * pr + 1, cps + 32 * (pr >> 5), 80u, c0, 2 * pr2, 2 * pr2 + 1, c1); TS(33); refresh(F);
                         swa_sample_pair<true, false>(F, 2 * pr2, 2 * pr2 + 1, cps + 32 * (pr2 >> 5), 80u, c1, 0, 0, c0); TS(35); }
              else { TS(32); swa_sample_pair<false, false>(F, 2 * pr, 2 * pr + 1, cps + 32 * (pr >> 5), 80u, c0, 0, 0, c1); TS(33); } } }
        TS(12);
    } SEAM(PH_INPROJ); TS(3);
    if (IN(PH_MIXA)) {
        swa_prompt_item(F, F.vcu);
        TSI(20);
        TSI(21);
        gla_super_a(F, F.vcu);
        TSI(22);
        gla_sample_pair(F, F.vcu);
        TSI(23);
    } SEAM(PH_MIXA); TS(4);
    if (IN(PH_MIXB)) {
        unsigned* cntm = (unsigned*)(F.ctl + CW_CNTM);
        gla_super_b(F, F.vcu); TSI(30);
        asm volatile("s_waitcnt vmcnt(0)" ::: "memory"); __syncthreads();
        { const int sup = F.vcu; const int pm = (sup >> 5) * 8 + (sup & 7);
          if (F.tid == 0) __hip_atomic_fetch_add(cntm + 32 * pm, 1u, __ATOMIC_RELAXED, __HIP_MEMORY_SCOPE_AGENT); }
        refresh(F);
        TS(5);
        { pg8::Gemm g{(const pg8::bf16_t*)(args.ws + WS_MIX), (const pg8::bf16_t*)(args.ws + WS_WOUT), NPR, D, D, D, D, GTS(PH_MIXB)}; pg8::OutPOrder S; S.init(F.vcu, D); S.cnt = cntm;
          pg8::EpiOutNorm E{args.in[IN_XP], (pg8::bf16_t*)(args.ws + WS_HB), (pg8::bf16_t*)(args.ws + WS_XN), MOD, NADA, args.in[IN_N2], (float*)(args.ws + WS_XS), (unsigned*)(F.ctl + CW_CNTX), (LAS float*)(F.lds + LDSCTL_OFF + 4096), EPS};
          pg8::gemm_phase<pg8::EpiOutNorm, pg8::OutPOrder, true, true>(F.lds + RING_OFF, g, S, E); }
    } SEAM(PH_MIXB); TS(6);
    if (IN(PH_FF1)) {
        unsigned* cntp = (unsigned*)(F.ctl + CW_CNTP); unsigned* cnts = (unsigned*)(F.ctl + CW_CNTS);
        unsigned* cntq = (unsigned*)(F.ctl + CW_CNTQ); unsigned* cntr = cntq + 4 * 32;
        { const int q = (int)blockIdx.x - 192; if (q >= 0) {
            pg8::Gemm g{(const pg8::bf16_t*)(args.ws + WS_MIXS_V), (const pg8::bf16_t*)(args.ws + WS_WOUT), MTOK, D, D, D, D, nullptr}; pg8::SubOnly<4> S; S.init(D, q, D); S.cnt = cntq;
            pg8::EpiGate<0> E{args.in[IN_XP], (pg8::bf16_t*)(args.ws + WS_HB), nullptr, MOD + 2048, NADA, (float*)(args.ws + WS_SLAB_OUT)};
            pg8::gemm_phase<pg8::EpiGate<0>, pg8::SubOnly<4>, true, true>(F.lds + RING_OFF, g, S, E); refresh(F);
            TS(40);
            norm2_sample(F, q, cntq, cntr); refresh(F);
            TS(43);
        } }
        { pg8::Gemm g{XN, (const pg8::bf16_t*)(args.ws + WS_W1), MTOK, FF, D, D, D, GTS(PH_FF1)}; pg8::Ff1Order S; S.init(FF, F.G, (int)blockIdx.x, D); S.cnt = cntp; S.cntr = cntr;
          pg8::EpiBf16WT<2> E{(pg8::bf16_t*)(args.ws + WS_HID), FFP, (size_t)MTOK * FFP * 2};
          pg8::gemm_phase<pg8::EpiBf16WT<2>, pg8::Ff1Order, true, true>(F.lds + RING_OFF, g, S, E); }
        TSI(8);
        { pg8::Gemm g{(const pg8::bf16_t*)(args.ws + WS_HID), (const pg8::bf16_t*)(args.ws + WS_W2), MTOK, D, FF, FFP, FFP, GTS(PH_FF2)}; pg8::Ff2Order<4> S; S.init(D, F.G, (int)blockIdx.x, FF, 64); S.cntp = cntp; S.cnts = cnts;
          pg8::EpiGate<1> E{nullptr, (pg8::bf16_t*)(args.ws + WS_HB), args.out + O_Y, MOD + 5120, NADA, (float*)(args.ws + WS_SLAB_FF2)};
          pg8::gemm_phase<pg8::EpiGate<1>, pg8::Ff2Order<4>, true, true>(F.lds + RING_OFF, g, S, E); }
        TSI(9);
        { const int s = (int)blockIdx.x - 128; if (s >= 0 && s < 64) {
            pg8::cnt_wait(cnts + 64 * (s >> 2), 32u);
            slab_reduce_rows(F, s >> 2, 64 * (s & 3));
        } }
    }
#if INSTR
    TS(10);
    if ((int)blockIdx.x == INSTR_BLOCK) {
        LAS float* sh = (LAS float*)(F.lds + RING_OFF);
        if (F.tid == 0) { asm volatile("s_waitcnt vmcnt(0)" ::: "memory"); const volatile unsigned long long* ts = (const volatile unsigned long long*)(F.ws + WS_CTL + 8192);
            const float d1 = (float)(long long)(ts[INSTR_B1] - ts[INSTR_A1]) * 0.01f, d2 = (float)(long long)(ts[INSTR_B2] - ts[INSTR_A2]) * 0.01f;
            F.out[O_CVP] += d1 * INSTR_S1; sh[0] = 0.005f + d2 * INSTR_S2; }
        __syncthreads();
        const float dl = sh[0];
        for (int i = F.tid; i < 131072; i += 512) F.out[O_CKP + i] += dl;
    }
#endif
#undef IN
#undef SEAM
#undef XN
#undef MOD
}

#ifndef LAUNCH_PLAN
#define LAUNCH_PLAN {0, 5}
#endif
extern "C" void kernel_launch(void* const* d_in, const int* in_sizes, int n_in, void* d_out, int out_size, void* d_ws, size_t ws_size, hipStream_t stream) {
    static int grid = 0;
    if (grid == 0) {
        if (n_in != 21 || out_size != (int)O_END || ws_size < WS_MIXS + 2 * MiB) { fprintf(stderr, "kernel_launch: unexpected shapes (n_in %d, out %d, ws %zu)\n", n_in, out_size, ws_size); grid = -1; return; }
        int dev = 0, cus = 0, per_cu = 0;
        if (hipGetDevice(&dev) != hipSuccess || hipDeviceGetAttribute(&cus, hipDeviceAttributeMultiprocessorCount, dev) != hipSuccess) { grid = -1; return; }
        if (hipFuncSetAttribute((const void*)fwd_kernel, hipFuncAttributeMaxDynamicSharedMemorySize, LDS_BYTES) != hipSuccess) { fprintf(stderr, "kernel_launch: hipFuncSetAttribute failed\n"); grid = -1; return; }
        if (hipOccupancyMaxActiveBlocksPerMultiprocessor(&per_cu, (const void*)fwd_kernel, NWAVES * 64, LDS_BYTES) != hipSuccess || per_cu < 1) { fprintf(stderr, "kernel_launch: occupancy query says %d\n", per_cu); }
        (void)hipGetLastError();
        grid = cus;
        if (grid != 256) { fprintf(stderr, "kernel_launch: built for a 256-CU device, found %d CUs; nothing launched\n", cus); grid = -1; return; }
    }
    if (grid < 0) return;
    (void)hipMemsetAsync((char*)d_ws + WS_CTL, 0, CTL_ZERO_BYTES, stream);
    Args a{};
    for (int i = 0; i < 21; ++i) a.in[i] = (const float*)d_in[i];
    a.out = (float*)d_out; a.ws = (unsigned char*)d_ws;
    for (int j = 0; j < 32; ++j) a.invf[j] = (float)pow(10000.0, -(double)j / 32.0);
    const int plan[] = LAUNCH_PLAN;
    for (unsigned li = 0; li + 1 < sizeof(plan) / sizeof(plan[0]); li += 2) { a.ph_lo = plan[li]; a.ph_hi = plan[li + 1]; a.li = (int)(li / 2);
        hipLaunchKernelGGL(fwd_kernel, dim3(grid), dim3(NWAVES * 64), LDS_BYTES, stream, a); }
}
```
